# Optimizing an MI355X kernel written in HIP

```python
import math
import jax, jax.numpy as jnp
from jax import lax
import numpy as np

D_MODEL = 1024
BATCH = 16
SEQ = 2048
DEPTH = 4

HEAD_DIM = 64
NSA_Q_HEADS = 6
NSA_KV_HEADS = 2
NSA_HPG = NSA_Q_HEADS // NSA_KV_HEADS
NSA_WIDTH = NSA_Q_HEADS * HEAD_DIM
N_BRANCH = 3
NSA_KV_COLS = N_BRANCH * 2 * NSA_KV_HEADS * HEAD_DIM
CMP_BLOCK = 32
CMP_STRIDE = 16
CMP_HIDDEN = 64
SEL_BLOCK = 64
SEL_TOP_N = 16
WINDOW = 512
FORCE_SCORE = 1.0e4
GLA_HEADS = 6
GLA_DK = 32
GLA_DV = 64
GLA_WIDTH = GLA_HEADS * GLA_DV
GLA_GATE_RANK = 16
GLA_GATE_NORM = 16.0
GLA_CHUNK = 64
POOL_WINDOWS = (2, 4, 8, 16)
POOL_GROUPS = 4
POOL_GROUP = 64
POOL_WIDTH = POOL_GROUPS * POOL_GROUP
MIX_WIDTH = NSA_WIDTH + GLA_WIDTH + POOL_WIDTH
SPLIT_SIZES = (NSA_WIDTH, NSA_KV_COLS, NSA_Q_HEADS * N_BRANCH,
               GLA_HEADS * GLA_DK, GLA_HEADS * GLA_DK, GLA_WIDTH, GLA_GATE_RANK, GLA_WIDTH,
               POOL_WIDTH)
P_IN = sum(SPLIT_SIZES)
D_FF = 4 * D_MODEL
ROPE_THETA = 500000.0
ROPE_DIM = HEAD_DIM // 4
Q_BLOCK = 128
SEL_Q_BLOCK = 32
LN_EPS = 1e-5
RMS_EPS = 1e-6
DEEPNORM_ALPHA = (2 * DEPTH) ** 0.25
DEEPNORM_BETA = (8 * DEPTH) ** -0.25

kernel_name = "hymba_nsa_gla_pool_deepnorm"


def partial_rope(x, pos):
    half = ROPE_DIM // 2
    inv = ROPE_THETA ** (-jnp.arange(half, dtype=jnp.float32) * 2.0 / ROPE_DIM)
    ang = pos.astype(jnp.float32)[:, None] * inv[None, :]
    cos = jnp.cos(ang).astype(x.dtype)
    sin = jnp.sin(ang).astype(x.dtype)
    x1, x2, xp = x[..., :half], x[..., half:ROPE_DIM], x[..., ROPE_DIM:]
    return jnp.concatenate([x1 * cos - x2 * sin, x1 * sin + x2 * cos, xp], axis=-1)


def layer_norm(x, g, b):
    xf = x.astype(jnp.float32)
    mu = jnp.mean(xf, -1, keepdims=True)
    var = jnp.mean(jnp.square(xf - mu), -1, keepdims=True)
    return ((xf - mu) * lax.rsqrt(var + LN_EPS)).astype(x.dtype) * g + b


def masked_softmax(s, mask):
    s = jnp.where(mask, s.astype(jnp.float32), -jnp.inf)
    m = jnp.max(s, -1, keepdims=True)
    m = jnp.where(jnp.isfinite(m), m, 0.0)
    e = jnp.exp(s - m)
    return e / jnp.maximum(jnp.sum(e, -1, keepdims=True), 1e-30)


def nsa_mixer(q, kv, gates, cmp_pos, cmp_w1, cmp_w2):
    B, S, _ = q.shape
    G, H, Dh = NSA_KV_HEADS, NSA_HPG, HEAD_DIM
    pos = jnp.arange(S)
    q = q.reshape(B, S, G, H, Dh).transpose(0, 2, 3, 1, 4)
    q = partial_rope(q, pos) * (Dh ** -0.5)
    kv = kv.reshape(B, S, N_BRANCH, 2, G, Dh).transpose(2, 3, 0, 4, 1, 5)

    n_cmp = (S - CMP_BLOCK) // CMP_STRIDE + 1
    blk_idx = CMP_STRIDE * jnp.arange(n_cmp)[:, None] + jnp.arange(CMP_BLOCK)[None, :]

    def compress(t, p, w1, w2):
        tb = t[:, :, blk_idx] + p
        hid = jax.nn.gelu(tb.reshape(B, G, n_cmp, CMP_BLOCK * Dh) @ w1)
        return hid @ w2

    kc = compress(partial_rope(kv[0, 0], pos), cmp_pos[0], cmp_w1[0], cmp_w2[0])
    vc = compress(kv[0, 1], cmp_pos[1], cmp_w1[1], cmp_w2[1])
    s_cmp = jnp.einsum('bghsd,bgnd->bghsn', q, kc)
    cmp_mask = blk_idx[:, -1][None, :] <= pos[:, None]
    p_cmp = masked_softmax(s_cmp, cmp_mask)
    o_cmp = jnp.einsum('bghsn,bgnd->bghsd', p_cmp.astype(vc.dtype), vc)

    n_sel = S // SEL_BLOCK
    n_top = min(SEL_TOP_N, n_sel)
    c_lo = blk_idx[:, 0:1]
    s_lo = (SEL_BLOCK * jnp.arange(n_sel))[None, :]
    overlap = jnp.clip(jnp.minimum(c_lo + CMP_BLOCK, s_lo + SEL_BLOCK) - jnp.maximum(c_lo, s_lo), 0, None)
    cmp_to_sel = overlap.astype(jnp.float32) / CMP_BLOCK
    imp = jnp.einsum('bghsn,nj->bgsj', p_cmp, cmp_to_sel)
    cur = (pos // SEL_BLOCK)[:, None]
    jb = jnp.arange(n_sel)[None, :]
    imp = jnp.where((jb == 0) | (jb == cur) | (jb == cur - 1), FORCE_SCORE, imp)
    imp = jnp.where(jb > cur, -FORCE_SCORE, imp)
    _, sel_idx = lax.top_k(imp, n_top)

    k_slc = partial_rope(kv[1, 0], pos).reshape(B, G, n_sel, SEL_BLOCK, Dh)
    v_slc = kv[1, 1].reshape(B, G, n_sel, SEL_BLOCK, Dh)
    nqb = S // SEL_Q_BLOCK
    q_blk = q.reshape(B, G, H, nqb, SEL_Q_BLOCK, Dh).transpose(3, 0, 1, 2, 4, 5)
    idx_blk = sel_idx.reshape(B, G, nqb, SEL_Q_BLOCK, n_top).transpose(2, 0, 1, 3, 4)
    t_blk = pos.reshape(nqb, SEL_Q_BLOCK)
    bi = jnp.arange(B)[:, None, None, None]
    gi = jnp.arange(G)[None, :, None, None]

    def sel_block(args):
        qb, ib, tb = args
        kb = k_slc[bi, gi, ib]
        vb = v_slc[bi, gi, ib]
        s = jnp.einsum('bghqd,bgqnkd->bghqnk', qb, kb)
        kpos = ib[..., None] * SEL_BLOCK + jnp.arange(SEL_BLOCK)
        m = (kpos <= tb[None, None, :, None, None])[:, :, None]
        s = s.reshape(B, G, H, SEL_Q_BLOCK, n_top * SEL_BLOCK)
        m = m.reshape(B, G, 1, SEL_Q_BLOCK, n_top * SEL_BLOCK)
        p = masked_softmax(s, m).reshape(B, G, H, SEL_Q_BLOCK, n_top, SEL_BLOCK)
        return jnp.einsum('bghqnk,bgqnkd->bghqd', p.astype(vb.dtype), vb)

    o_slc = lax.map(sel_block, (q_blk, idx_blk, t_blk))
    o_slc = o_slc.transpose(1, 2, 3, 0, 4, 5).reshape(B, G, H, S, Dh)

    pad = ((0, 0), (0, 0), (WINDOW, 0), (0, 0))
    k_win = jnp.pad(partial_rope(kv[2, 0], pos), pad)
    v_win = jnp.pad(kv[2, 1], pad)
    nwb = S // Q_BLOCK
    span = WINDOW + Q_BLOCK
    q_wb = q.reshape(B, G, H, nwb, Q_BLOCK, Dh).transpose(3, 0, 1, 2, 4, 5)
    starts = jnp.arange(nwb) * Q_BLOCK

    def win_block(args):
        qb, s0 = args
        kb = lax.dynamic_slice_in_dim(k_win, s0, span, axis=2)
        vb = lax.dynamic_slice_in_dim(v_win, s0, span, axis=2)
        s = jnp.einsum('bghqd,bgkd->bghqk', qb, kb)
        tq = s0 + jnp.arange(Q_BLOCK)
        tk = s0 - WINDOW + jnp.arange(span)
        diff = tq[:, None] - tk[None, :]
        m = (diff >= 0) & (diff < WINDOW) & (tk[None, :] >= 0)
        p = masked_softmax(s, m)
        return jnp.einsum('bghqk,bgkd->bghqd', p.astype(vb.dtype), vb)

    o_win = lax.map(win_block, (q_wb, starts))
    o_win = o_win.transpose(1, 2, 3, 0, 4, 5).reshape(B, G, H, S, Dh)

    gt = jax.nn.sigmoid(gates.reshape(B, S, G, H, N_BRANCH).transpose(0, 2, 3, 1, 4))
    o = gt[..., 0:1] * o_cmp + gt[..., 1:2] * o_slc + gt[..., 2:3] * o_win
    return o.transpose(0, 3, 1, 2, 4).reshape(B, S, NSA_WIDTH)


def gla_mixer(q, k, v, g_lr, og, w_gate2, b_gate, norm_g):
    B, S, _ = q.shape
    Hh, dk, dv, C = GLA_HEADS, GLA_DK, GLA_DV, GLA_CHUNK
    N = S // C
    f32 = jnp.float32
    gk = jax.nn.log_sigmoid((g_lr @ w_gate2 + b_gate).astype(f32)) / GLA_GATE_NORM

    def chunks(t, d):
        return t.astype(f32).reshape(B, N, C, Hh, d).transpose(0, 3, 1, 2, 4)

    qc = chunks(q, dk) * (dk ** -0.5)
    kc = chunks(k, dk)
    vc = chunks(v, dv)
    bcum = jnp.cumsum(chunks(gk, dk), axis=3)
    blast = bcum[:, :, :, -1:]
    q_dec = qc * jnp.exp(bcum)
    k_inv = kc * jnp.exp(-bcum)
    k_end = kc * jnp.exp(blast - bcum)
    causal = jnp.tril(jnp.ones((C, C), bool))
    a = jnp.where(causal, jnp.einsum('bhnid,bhnjd->bhnij', q_dec, k_inv), 0.0)
    o_intra = jnp.einsum('bhnij,bhnjv->bhniv', a, vc)
    d_state = jnp.einsum('bhncd,bhncv->bhndv', k_end, vc)
    decay = jnp.exp(blast[:, :, :, 0])

    def step(s_prev, inp):
        dcy, ds = inp
        return s_prev * dcy[..., None] + ds, s_prev

    _, s_in = lax.scan(step, jnp.zeros((B, Hh, dk, dv), f32),
                       (decay.transpose(2, 0, 1, 3), d_state.transpose(2, 0, 1, 3, 4)))
    s_in = s_in.transpose(1, 2, 0, 3, 4)
    o = o_intra + jnp.einsum('bhncd,bhndv->bhncv', q_dec, s_in)
    o = o * lax.rsqrt(jnp.mean(o * o, -1, keepdims=True) + RMS_EPS)
    o = o.transpose(0, 2, 3, 1, 4).reshape(B, S, GLA_WIDTH).astype(og.dtype)
    return o * norm_g * jax.nn.silu(og)


def pool_mixer(u, w_pool, scale):
    B, S, Cw = u.shape
    uf = u.astype(jnp.float32)
    cs = jnp.pad(jnp.cumsum(uf, axis=1), ((0, 0), (1, 0), (0, 0)))
    win = jnp.repeat(jnp.array(POOL_WINDOWS, jnp.int32), POOL_GROUP)
    t = jnp.arange(S)[:, None]
    lo = jnp.maximum(t + 1 - win[None, :], 0)
    cnt = jnp.minimum(t + 1, win[None, :]).astype(jnp.float32)
    lo_sum = jnp.take_along_axis(cs, jnp.broadcast_to(lo[None], (B, S, Cw)), axis=1)
    pooled = (cs[:, 1:] - lo_sum) / cnt - uf
    y = jnp.einsum('bsgc,gcd->bsgd', pooled.reshape(B, S, POOL_GROUPS, POOL_GROUP).astype(u.dtype), w_pool)
    return y.reshape(B, S, POOL_WIDTH) * scale


def setup_inputs(seed: int = 0) -> dict:
    key = jax.random.key(seed)
    ks = jax.random.split(key, 20)
    L, D = DEPTH, D_MODEL
    nrm = lambda k, shape, s: jax.random.normal(k, shape, jnp.float32) * s
    return {
        "x": nrm(ks[0], (BATCH, SEQ, D), 1.0),
        "w_in": nrm(ks[1], (L, D, P_IN), D ** -0.5),
        "cmp_pos": nrm(ks[2], (L, 2, CMP_BLOCK, HEAD_DIM), 0.1),
        "cmp_w1": nrm(ks[3], (L, 2, CMP_BLOCK * HEAD_DIM, CMP_HIDDEN), (CMP_BLOCK * HEAD_DIM) ** -0.5),
        "cmp_w2": nrm(ks[4], (L, 2, CMP_HIDDEN, HEAD_DIM), CMP_HIDDEN ** -0.5),
        "gla_w_gate2": nrm(ks[5], (L, GLA_GATE_RANK, GLA_HEADS * GLA_DK), GLA_GATE_RANK ** -0.5),
        "gla_b_gate": nrm(ks[6], (L, GLA_HEADS * GLA_DK), 0.01),
        "gla_norm_g": 1.0 + nrm(ks[7], (L, GLA_WIDTH), 0.02),
        "pool_w": nrm(ks[8], (L, POOL_GROUPS, POOL_GROUP, POOL_GROUP), POOL_GROUP ** -0.5),
        "pool_scale": 1.0 + nrm(ks[9], (L, POOL_WIDTH), 0.02),
        "w_out": nrm(ks[10], (L, MIX_WIDTH, D), MIX_WIDTH ** -0.5 * DEEPNORM_BETA),
        "ln1_g": 1.0 + nrm(ks[11], (L, D), 0.02),
        "ln1_b": nrm(ks[12], (L, D), 0.02),
        "w_up": nrm(ks[13], (L, D, D_FF), D ** -0.5),
        "w_down": nrm(ks[14], (L, D_FF, D), D_FF ** -0.5 * DEEPNORM_BETA),
        "ln2_g": 1.0 + nrm(ks[15], (L, D), 0.02),
        "ln2_b": nrm(ks[16], (L, D), 0.02),
    }


def reference(x, w_in, cmp_pos, cmp_w1, cmp_w2, gla_w_gate2, gla_b_gate, gla_norm_g, pool_w, pool_scale,
              w_out, ln1_g, ln1_b, w_up, w_down, ln2_g, ln2_b):
    split_points = []
    acc = 0
    for sz in SPLIT_SIZES[:-1]:
        acc += sz
        split_points.append(acc)
    h = x
    for l in range(DEPTH):
        proj = h @ w_in[l]
        nq, nkv, ngate, gq, gk, gv, glr, gog, pu = jnp.split(proj, split_points, axis=-1)
        mixed = jnp.concatenate([
            nsa_mixer(nq, nkv, ngate, cmp_pos[l], cmp_w1[l], cmp_w2[l]),
            gla_mixer(gq, gk, gv, glr, gog, gla_w_gate2[l], gla_b_gate[l], gla_norm_g[l]),
            pool_mixer(pu, pool_w[l], pool_scale[l]),
        ], axis=-1)
        h = layer_norm(DEEPNORM_ALPHA * h + mixed @ w_out[l], ln1_g[l], ln1_b[l])
        ff = jnp.square(jax.nn.relu(h @ w_up[l])) @ w_down[l]
        h = layer_norm(DEEPNORM_ALPHA * h + ff, ln2_g[l], ln2_b[l])
    return h
```

```cpp
#include <hip/hip_runtime.h>
#include <cstdio>
#include <cstdint>
__device__ __forceinline__ float shx(float v, int mask, int lane) { return __builtin_bit_cast(float, __builtin_amdgcn_ds_bpermute((lane ^ mask) << 2, __builtin_bit_cast(int, v))); }
__device__ __forceinline__ unsigned shxu(unsigned v, int mask, int lane) { return (unsigned)__builtin_amdgcn_ds_bpermute((lane ^ mask) << 2, (int)v); }
namespace pg8 {
#define PG8_LAS __attribute__((address_space(3)))
typedef unsigned short bf16_t;
typedef short bf16x8 __attribute__((ext_vector_type(8)));
typedef float f32x4 __attribute__((ext_vector_type(4)));
typedef unsigned u32x4 __attribute__((ext_vector_type(4)));
constexpr int BM = 256, BK = 64, HALF = 128, HTB = HALF * BK * 2  , STAGE_BYTES = 8 * HTB, NXCD = 8, WGM = 8;

__host__ __device__ __forceinline__ int lds_byte(int r, int c) { const int st = (r >> 4) * 2 + (c >> 5), rr = r & 15, cc = c & 31, ob = rr * 64 + cc * 2; return st * 1024 + (ob ^ (((ob >> 9) & 1) << 5)); }
__host__ __device__ __forceinline__ void stage_rc(int b, int& R, int& C) { const int st = b / 1024, sb = b % 1024, swz = sb ^ (((sb >> 9) & 1) << 5); R = (st >> 1) * 16 + swz / 64; C = (st & 1) * 32 + (swz % 64) / 2; }
__host__ __device__ __forceinline__ int perm32(int rho) { const int n = rho >> 4, i = rho & 15; return 8 * (i >> 2) + 4 * n + (i & 3); }

struct Unit { int pm, pn; };
struct Gemm { const bf16_t* A; const bf16_t* Bt; int M, N, K; size_t apad = 0; };

struct StaticOrder {
    int nM, nN, nwg, G, c;
    __host__ __device__ void init(int M, int N, int G_, int c_) { nM = M / BM; nN = N / BM; nwg = nM * nN; G = G_; c = c_; }
    __host__ __device__ bool next(int i, Unit& u) const {
        const long L = (long)i * G + c; if (L >= nwg) return false;
        int wgid = (int)L; { const int q = nwg / NXCD, r = nwg % NXCD, xcd = wgid % NXCD, off = wgid / NXCD; wgid = (xcd < r ? xcd * (q + 1) : r * (q + 1) + (xcd - r) * q) + off; }
        const int nig = WGM * nN, gid = wgid / nig, fm = gid * WGM, gsz = (nM - fm) < WGM ? (nM - fm) : WGM;
        u.pm = fm + ((wgid % nig) % gsz); u.pn = (wgid % nig) / gsz; return true;
    }
    __device__ __forceinline__ void a_ready(const Unit&) const {}
    __device__ __forceinline__ void done(const Unit&) const {}
};

__device__ __forceinline__ unsigned cvt_pk_bf16(float lo, float hi) { unsigned r; asm volatile("v_cvt_pk_bf16_f32 %0, %1, %2" : "=v"(r) : "v"(lo), "v"(hi)); return r; }
typedef float f32x2 __attribute__((ext_vector_type(2)));
constexpr float LNF_EPS = 1e-5f;
__device__ __forceinline__ void row_stats_finish(f32x2 v, float& mu, float& rstd, int lane) {
    float s = v[0], ss = v[1];
    s += shx(s, 16, lane); ss += shx(ss, 16, lane); s += shx(s, 32, lane); ss += shx(ss, 32, lane);
    mu = s * (1.0f / 1024.0f); const float var = fmaxf(ss * (1.0f / 1024.0f) - mu * mu, 0.f); rstd = __builtin_amdgcn_rsqf(var + LNF_EPS);
}
__device__ __forceinline__ void row_stats8_load(const float* st, int row0, int fq, f32x2 (&raw)[8]) {
#pragma unroll
    for (int i = 0; i < 8; ++i) raw[i] = *(const f32x2*)(st + (size_t)(row0 + (i >> 2) * HALF + (i & 3) * 16) * 8 + 2 * fq);
}
struct EpiProj {
    static constexpr bool PERM = true, AFTER_DRAIN = false, CONTIG = true;
    bf16_t* O; const float* rope; int ldc; float qscale; const float* st; const float* c1; const float* c2; size_t opad;
    __device__ __forceinline__ void operator()(const f32x4 (&acc)[2][2][4][2], const Unit& u, int wr, int wc, int fr, int fq, PG8_LAS unsigned char*, int) const {
        const int row0 = u.pm * BM + wr * 64 + fr;
        const int cg0 = u.pn * BM + wc * 64, h64 = cg0 >> 6;
        const bool roped = (h64 < 6 || (h64 < 18 && (((h64 - 6) >> 1) & 1) == 0));
        const float sc = (cg0 < 384) ? qscale : 1.0f;
        f32x4 k1[2][2], k2[2][2];
#pragma unroll
        for (int bj = 0; bj < 2; ++bj)
#pragma unroll
            for (int n = 0; n < 2; ++n) { k1[bj][n] = (f32x4){0.f, 0.f, 0.f, 0.f}; k2[bj][n] = k1[bj][n];
                if (st) { k1[bj][n] = *(const f32x4*)(c1 + cg0 + bj * 32 + 8 * fq + 4 * n); k2[bj][n] = *(const f32x4*)(c2 + cg0 + bj * 32 + 8 * fq + 4 * n); } }
        f32x2 raw[8];
#pragma unroll
        for (int i = 0; i < 8; ++i) raw[i] = (f32x2){0.f, 0.f};
        if (st) row_stats8_load(st, row0, fq, raw);
        const bool odd = fr & 1;
        bf16_t* const obase = O + (size_t)(u.pm >> 4) * opad + (size_t)(row0 - (fr & 1)) * ldc + cg0 + (fr & 1) * 32 + 8 * fq;
#pragma unroll
        for (int ai = 0; ai < 2; ++ai)
#pragma unroll
            for (int m = 0; m < 4; ++m) {
                const int row = row0 + ai * HALF + m * 16;
                float mu = 0.f, rs = 1.f; if (st) row_stats_finish(raw[ai * 4 + m], mu, rs, fr + 16 * fq);
                u32x4 w[2];
#pragma unroll
                for (int bj = 0; bj < 2; ++bj) {
                    f32x4 v0 = (acc[ai][bj][m][0] - k1[bj][0] * mu) * rs + k2[bj][0], v1 = (acc[ai][bj][m][1] - k1[bj][1] * mu) * rs + k2[bj][1];
                    if (bj == 0 && roped) {
                        f32x4 o0, o1;
#pragma unroll
                        for (int e = 0; e < 4; ++e) { o0[e] = shx(v0[e], 16, fr + 16 * fq); o1[e] = shx(v1[e], 16, fr + 16 * fq); }
                        if (fq < 2) {
                            const float* rp = rope + (size_t)(row & 2047) * 16;
                            const f32x4 c0 = *(const f32x4*)(rp), cc1 = *(const f32x4*)(rp + 4), s0 = *(const f32x4*)(rp + 8), s1 = *(const f32x4*)(rp + 12);
                            const float sg = (fq == 0) ? -1.0f : 1.0f;
                            v0 = v0 * c0 + o0 * (s0 * sg); v1 = v1 * cc1 + o1 * (s1 * sg);
                        }
                    }
                    v0 = v0 * sc; v1 = v1 * sc;
                    w[bj].x = cvt_pk_bf16(v0[0], v0[1]); w[bj].y = cvt_pk_bf16(v0[2], v0[3]); w[bj].z = cvt_pk_bf16(v1[0], v1[1]); w[bj].w = cvt_pk_bf16(v1[2], v1[3]);
                }
                u32x4 wa, wb;
#pragma unroll
                for (int e = 0; e < 4; ++e) { const unsigned snd = odd ? w[0][e] : w[1][e];
                    const unsigned rcv = (unsigned)__builtin_amdgcn_update_dpp(0, (int)snd, 0xB1, 0xF, 0xF, true);
                    wa[e] = odd ? rcv : w[0][e]; wb[e] = odd ? w[1][e] : rcv; }
                bf16_t* rowp = obase + (size_t)(ai * HALF + m * 16) * ldc;
                *(u32x4*)rowp = wa; *(u32x4*)(rowp + ldc) = wb;
            }
    }
};
struct EpiRelu2 {
    static constexpr bool PERM = true, AFTER_DRAIN = false, CONTIG = true;
    bf16_t* O; int ldc; const float* st; const float* c1; const float* c2;
    __device__ __forceinline__ void operator()(const f32x4 (&acc)[2][2][4][2], const Unit& u, int wr, int wc, int fr, int fq, PG8_LAS unsigned char* l, int t) const { run<true>(acc, u, wr, wc, fr, fq, l, t); }
    template <bool STORE>
    __device__ __forceinline__ void run(const f32x4 (&acc)[2][2][4][2], const Unit& u, int wr, int wc, int fr, int fq, PG8_LAS unsigned char*, int) const {
        const int row0 = u.pm * BM + wr * 64 + fr; const int col0 = u.pn * BM + wc * 64 + 8 * fq;
        f32x4 k1[2][2], k2[2][2];
#pragma unroll
        for (int bj = 0; bj < 2; ++bj)
#pragma unroll
            for (int n = 0; n < 2; ++n) { k1[bj][n] = *(const f32x4*)(c1 + col0 + bj * 32 + 4 * n); k2[bj][n] = *(const f32x4*)(c2 + col0 + bj * 32 + 4 * n); }
        f32x2 raw[8]; row_stats8_load(st, row0, fq, raw);
        const bool odd = fr & 1;
        bf16_t* const obase = O + (size_t)(row0 - (fr & 1)) * ldc + col0 + (fr & 1) * 32;
#pragma unroll
        for (int ai = 0; ai < 2; ++ai)
#pragma unroll
            for (int m = 0; m < 4; ++m) { float mu, rs; row_stats_finish(raw[ai * 4 + m], mu, rs, fr + 16 * fq);
                u32x4 w[2];
#pragma unroll
                for (int bj = 0; bj < 2; ++bj) { f32x4 v0 = (acc[ai][bj][m][0] - k1[bj][0] * mu) * rs + k2[bj][0], v1 = (acc[ai][bj][m][1] - k1[bj][1] * mu) * rs + k2[bj][1];
#pragma unroll
                    for (int e = 0; e < 4; ++e) { const float a = fmaxf(v0[e], 0.f), b = fmaxf(v1[e], 0.f); v0[e] = a * a; v1[e] = b * b; }
                    w[bj].x = cvt_pk_bf16(v0[0], v0[1]); w[bj].y = cvt_pk_bf16(v0[2], v0[3]); w[bj].z = cvt_pk_bf16(v1[0], v1[1]); w[bj].w = cvt_pk_bf16(v1[2], v1[3]); }
                u32x4 wa, wb;
#pragma unroll
                for (int e = 0; e < 4; ++e) { const unsigned snd = odd ? w[0][e] : w[1][e];
                    const unsigned rcv = (unsigned)__builtin_amdgcn_update_dpp(0, (int)snd, 0xB1, 0xF, 0xF, true);
                    wa[e] = odd ? rcv : w[0][e]; wb[e] = odd ? w[1][e] : rcv; }
                bf16_t* rowp = obase + (size_t)(ai * HALF + m * 16) * ldc;
                if (STORE) { *(u32x4*)rowp = wa; *(u32x4*)(rowp + ldc) = wb; } else { asm volatile("" :: "v"(wa)); asm volatile("" :: "v"(wb)); } }
    }
};
struct EpiRes {
    static constexpr bool PERM = true, AFTER_DRAIN = false, CONTIG = true;
    const float* resf; bf16_t* xb; float* stb; const float* gb; int ldc, k_in, k_out; float alpha;
    __device__ __forceinline__ void operator()(f32x4 (&acc)[2][2][4][2], const Unit& u, int wr, int wc, int fr, int fq, PG8_LAS unsigned char* lds, int tid) const {
        const int col0 = u.pn * BM + wc * 64 + 8 * fq;
        const float* st_in = stb + (size_t)(k_in & 1) * (32768 * 8); float* st_out = stb + (size_t)(k_out & 1) * (32768 * 8);
        PG8_LAS f32x2* P = (PG8_LAS f32x2*)(lds + STAGE_BYTES);
        f32x4 gv[2][2], bv[2][2];
#pragma unroll
        for (int bj = 0; bj < 2; ++bj)
#pragma unroll
            for (int n = 0; n < 2; ++n) { gv[bj][n] = (f32x4){1.f, 1.f, 1.f, 1.f}; bv[bj][n] = (f32x4){0.f, 0.f, 0.f, 0.f};
                if (!resf) { gv[bj][n] = *(const f32x4*)(gb + col0 + bj * 32 + n * 4); bv[bj][n] = *(const f32x4*)(gb + 1024 + col0 + bj * 32 + n * 4); } }
        int frl = fr; asm volatile("" : "+v"(frl));
        const bool odd = frl & 1;
        const int colw = u.pn * BM + wc * 64 + (frl & 1) * 32 + 8 * fq;
        u32x4 rwq[3][2]; f32x2 stq[3];
#define EPIRES_REQ(i_) do { const int row_ = u.pm * BM + ((i_) >> 2) * HALF + wr * 64 + ((i_) & 3) * 16 + frl; const size_t off_ = (size_t)(row_ - (frl & 1)) * ldc + colw; \
            if (!resf) { stq[(i_) % 3] = *(const f32x2*)(st_in + (size_t)row_ * 8 + 2 * fq); \
                rwq[(i_) % 3][0] = *(const u32x4*)(xb + off_); rwq[(i_) % 3][1] = *(const u32x4*)(xb + off_ + ldc); } } while (0)
        EPIRES_REQ(0); EPIRES_REQ(1);
        PG8_LAS f32x2* const Pl = P + (wr * 64 + frl) * 4 + wc;
#pragma unroll
        for (int i = 0; i < 8; ++i) { const int ai = i >> 2, m = i & 3;
            const int rl = ai * HALF + wr * 64 + m * 16 + frl, row = u.pm * BM + rl; const size_t off = (size_t)row * ldc + col0;
            if (i + 2 < 8) EPIRES_REQ(i + 2);
            float mu = 0.f, rs = 1.f; if (!resf) row_stats_finish(stq[i % 3], mu, rs, fr + 16 * fq);
            u32x4 own[2];
            if (!resf) {
#pragma unroll
                for (int e = 0; e < 4; ++e) { const unsigned a_ = rwq[i % 3][0][e], b_ = rwq[i % 3][1][e]; const unsigned snd = odd ? a_ : b_;
                    const unsigned rcv = (unsigned)__builtin_amdgcn_update_dpp(0, (int)snd, 0xB1, 0xF, 0xF, true);
                    own[0][e] = odd ? rcv : a_; own[1][e] = odd ? b_ : rcv; }
            }
            float s = 0.f, ss = 0.f; u32x4 wo[2];
#pragma unroll
            for (int bj = 0; bj < 2; ++bj) {
#pragma unroll
                for (int n = 0; n < 2; ++n) { f32x4 r;
                    if (resf) r = *(const f32x4*)(resf + off + bj * 32 + n * 4);
                    else { const unsigned w0 = own[bj][2 * n], w1 = own[bj][2 * n + 1];
                           r[0] = __builtin_bit_cast(float, w0 << 16); r[1] = __builtin_bit_cast(float, w0 & 0xffff0000u); r[2] = __builtin_bit_cast(float, w1 << 16); r[3] = __builtin_bit_cast(float, w1 & 0xffff0000u); }
                    const f32x4 h = (r - mu) * rs * gv[bj][n] + bv[bj][n];
                    const f32x4 y = h * alpha + acc[ai][bj][m][n];
                    const unsigned p0 = cvt_pk_bf16(y[0], y[1]), p1 = cvt_pk_bf16(y[2], y[3]); wo[bj][2 * n] = p0; wo[bj][2 * n + 1] = p1;
                    const float y0 = __builtin_bit_cast(float, p0 << 16), y1 = __builtin_bit_cast(float, p0 & 0xffff0000u), y2 = __builtin_bit_cast(float, p1 << 16), y3 = __builtin_bit_cast(float, p1 & 0xffff0000u);
                    s += (y0 + y1) + (y2 + y3); ss += (y0 * y0 + y1 * y1) + (y2 * y2 + y3 * y3); } }
            { u32x4 wa, wb;
#pragma unroll
              for (int e = 0; e < 4; ++e) { const unsigned snd = odd ? wo[0][e] : wo[1][e];
                  const unsigned rcv = (unsigned)__builtin_amdgcn_update_dpp(0, (int)snd, 0xB1, 0xF, 0xF, true);
                  wa[e] = odd ? rcv : wo[0][e]; wb[e] = odd ? wo[1][e] : rcv; }
              bf16_t* wp = xb + (size_t)(row - (frl & 1)) * ldc + colw;
              *(u32x4*)wp = wa; *(u32x4*)(wp + ldc) = wb; }
            s += shx(s, 16, fr + 16 * fq); s += shx(s, 32, fr + 16 * fq); ss += shx(ss, 16, fr + 16 * fq); ss += shx(ss, 32, fr + 16 * fq);
            if (fq == 0) Pl[(ai * HALF + m * 16) * 4] = (f32x2){s, ss}; }
#undef EPIRES_REQ
        asm volatile("s_waitcnt lgkmcnt(0)" ::: "memory"); __builtin_amdgcn_s_barrier(); asm volatile("" ::: "memory");
        asm volatile("" : "+v"(tid));
        if (tid < 256) { const f32x2 a = P[tid * 4 + 0], b = P[tid * 4 + 1], c = P[tid * 4 + 2], d = P[tid * 4 + 3];
            *(f32x2*)(st_out + (size_t)(u.pm * BM + tid) * 8 + 2 * u.pn) = (f32x2){(a[0] + b[0]) + (c[0] + d[0]), (a[1] + b[1]) + (c[1] + d[1])}; }
    }
};
template <class Epi, class Sched, bool ALIGN_EPI = false, bool SP2 = false>
__device__ __forceinline__ void gemm_phase(PG8_LAS unsigned char* lds, const Gemm g, const Sched& S, const Epi& E, int wave_id) {
    unsigned mk_ = ~0u; asm volatile("" : "+s"(mk_)); int lane_ = (int)__builtin_amdgcn_mbcnt_hi(mk_, __builtin_amdgcn_mbcnt_lo(mk_, 0u)); asm volatile("" : "+v"(lane_)); asm volatile("" : "+s"(wave_id));
    const int tid = wave_id * 64 + lane_, wid = wave_id, lane = tid & 63, wr = wid >> 2, wc = wid & 3, fr = lane & 15, fq = lane >> 4;
    const int K = g.K, nt = K / BK;
    unsigned voffA[2], voffB[2];
#pragma unroll
    for (int i = 0; i < 2; ++i) { int R, C; stage_rc(tid * 16 + i * 8192, R, C); const int r5 = Epi::PERM ? perm32(R & 31) : (R & 31); const int Rb = Epi::CONTIG ? ((R >> 5) * 64 + r5) : ((R & ~31) + r5);
        voffA[i] = (unsigned)(R * K + C) * 2u; voffB[i] = (unsigned)(Rb * K + C) * 2u; }
    const size_t kstep = (size_t)(BK * 2);
    const size_t hstep = (size_t)HALF * K * 2;
    const size_t hstepB = Epi::CONTIG ? (size_t)32 * K * 2 : hstep;
    const size_t tstep = 2 * hstep;
    const unsigned ldsw = (unsigned)wid * 1024u;
    const int aoff = lds_byte(wr * 64 + fr, fq * 8), boff = lds_byte(wc * 32 + fr, fq * 8);
#define PG8_SA(b, h) (((b) * 2 + (h)) * HTB)
#define PG8_SB(b, h) ((4 + (b) * 2 + (h)) * HTB)
#define PG8_STAGE(bufoff, gbase, voff) do { _Pragma("unroll") for (int _i = 0; _i < 2; ++_i) \
        __builtin_amdgcn_global_load_lds((const unsigned*)((const char*)(gbase) + (voff)[_i]), (PG8_LAS unsigned*)(lds + (bufoff) + ldsw + _i * 8192), 16, 0, 0); } while (0)
#define PG8_LDA(dst, b, h) do { _Pragma("unroll") for (int m = 0; m < 4; ++m) _Pragma("unroll") for (int k = 0; k < 2; ++k) dst[m][k] = *(const PG8_LAS bf16x8*)(lds + PG8_SA(b, h) + aoff + m * 2048 + k * 1024); } while (0)
#define PG8_LDB(dst, b, h) do { _Pragma("unroll") for (int n = 0; n < 2; ++n) _Pragma("unroll") for (int k = 0; k < 2; ++k) dst[n][k] = *(const PG8_LAS bf16x8*)(lds + PG8_SB(b, h) + boff + n * 2048 + k * 1024); } while (0)
#define PG8_MMA(ai, bj, At, Bt) do { __builtin_amdgcn_s_setprio(1); _Pragma("unroll") for (int m = 0; m < 4; ++m) _Pragma("unroll") for (int n = 0; n < 2; ++n) _Pragma("unroll") for (int k = 0; k < 2; ++k) \
        acc[ai][bj][m][n] = __builtin_amdgcn_mfma_f32_16x16x32_bf16(Bt[n][k], At[m][k], acc[ai][bj][m][n], 0, 0, 0); __builtin_amdgcn_s_setprio(0); } while (0)
#define PG8_WAIT_V(n) asm volatile("s_waitcnt vmcnt(" #n ")" ::: "memory")
#define PG8_WAIT_L(n) asm volatile("s_waitcnt lgkmcnt(" #n ")" ::: "memory")
#define PG8_BAR __builtin_amdgcn_s_barrier()
#define PG8_SCHED __builtin_amdgcn_sched_barrier(0)
    Unit cur, nxt; int ui = 0;
    if (!S.next(0, cur)) return;
    f32x4 acc[2][2][4][2];
#pragma unroll
    for (int a = 0; a < 2; ++a)
#pragma unroll
        for (int b = 0; b < 2; ++b)
#pragma unroll
            for (int m = 0; m < 4; ++m)
#pragma unroll
                for (int n = 0; n < 2; ++n) acc[a][b][m][n] = (f32x4){0.f, 0.f, 0.f, 0.f};
    bf16x8 At[4][2], B0[2][2], B1[2][2];
    const char* cA = (const char*)g.A + (size_t)cur.pm * tstep + (size_t)(cur.pm >> 4) * g.apad; const char* cB = (const char*)g.Bt + (size_t)cur.pn * tstep;
    S.a_ready(cur);
    if constexpr (SP2) {
        PG8_STAGE(PG8_SB(0, 0), cB, voffB); PG8_STAGE(PG8_SB(0, 1), cB + hstepB, voffB); PG8_STAGE(PG8_SA(0, 0), cA, voffA); PG8_STAGE(PG8_SA(0, 1), cA + hstep, voffA);
        if (wr == 1) PG8_BAR;
        PG8_WAIT_V(2); PG8_BAR;
        PG8_STAGE(PG8_SB(1, 0), cB + kstep, voffB); PG8_STAGE(PG8_SA(1, 0), cA + kstep, voffA); PG8_STAGE(PG8_SB(1, 1), cB + hstepB + kstep, voffB);
        PG8_WAIT_V(6); PG8_BAR;
    } else {
        PG8_STAGE(PG8_SB(0, 0), cB, voffB); PG8_STAGE(PG8_SA(0, 0), cA, voffA); PG8_STAGE(PG8_SB(0, 1), cB + hstepB, voffB); PG8_STAGE(PG8_SA(0, 1), cA + hstep, voffA);
        if (wr == 1) PG8_BAR;
        PG8_WAIT_V(4); PG8_BAR;
        PG8_STAGE(PG8_SB(1, 0), cB + kstep, voffB); PG8_STAGE(PG8_SA(1, 0), cA + kstep, voffA); PG8_STAGE(PG8_SB(1, 1), cB + hstepB + kstep, voffB);
        PG8_WAIT_V(6); PG8_BAR;
    }
    for (;;) {
        const bool has_next = S.next(ui + 1, nxt);
        const char* nA = has_next ? (const char*)g.A + (size_t)nxt.pm * tstep + (size_t)(nxt.pm >> 4) * g.apad : cA; const char* nB = has_next ? (const char*)g.Bt + (size_t)nxt.pn * tstep : cB;
        for (int t = 0; t < nt; t += 2) {
            const bool last = (t == nt - 2);
            const char* a1 = cA + (size_t)(t + 1) * kstep;
            const char* a2 = last ? nA : cA + (size_t)(t + 2) * kstep; const char* b2 = last ? nB : cB + (size_t)(t + 2) * kstep;
            const char* a3 = a2 + kstep; const char* b3 = b2 + kstep;
            if (last && has_next) S.a_ready(nxt);
            if constexpr (SP2) {
            PG8_LDB(B0, 0, 0); PG8_LDB(B1, 0, 1); PG8_SCHED; PG8_LDA(At, 0, 0); PG8_STAGE(PG8_SA(1, 1), a1 + hstep, voffA);
            PG8_WAIT_V(8); PG8_WAIT_L(0); PG8_BAR; PG8_MMA(0, 0, At, B0); PG8_MMA(0, 1, At, B1); PG8_BAR; PG8_SCHED;
            PG8_LDA(At, 0, 1); PG8_STAGE(PG8_SB(0, 0), b2, voffB); PG8_STAGE(PG8_SB(0, 1), b2 + hstepB, voffB); PG8_STAGE(PG8_SA(0, 0), a2, voffA);
            PG8_WAIT_V(8); PG8_WAIT_L(0); PG8_BAR; PG8_MMA(1, 0, At, B0); PG8_MMA(1, 1, At, B1); PG8_BAR; PG8_SCHED;
            PG8_LDB(B0, 1, 0); PG8_LDB(B1, 1, 1); PG8_SCHED; PG8_LDA(At, 1, 0); PG8_STAGE(PG8_SA(0, 1), a2 + hstep, voffA);
            PG8_WAIT_V(8); PG8_WAIT_L(0); PG8_BAR; PG8_MMA(0, 0, At, B0); PG8_MMA(0, 1, At, B1); PG8_BAR; PG8_SCHED;
            PG8_LDA(At, 1, 1); PG8_STAGE(PG8_SB(1, 0), b3, voffB); PG8_STAGE(PG8_SB(1, 1), b3 + hstepB, voffB); PG8_STAGE(PG8_SA(1, 0), a3, voffA);
            PG8_WAIT_V(8); PG8_WAIT_L(0); PG8_BAR; PG8_MMA(1, 0, At, B0); PG8_MMA(1, 1, At, B1); PG8_BAR; PG8_SCHED;
            } else {
            PG8_LDB(B0, 0, 0); PG8_SCHED; PG8_LDA(At, 0, 0); PG8_STAGE(PG8_SA(1, 1), a1 + hstep, voffA);
            PG8_WAIT_L(8); PG8_BAR; PG8_WAIT_L(0); PG8_MMA(0, 0, At, B0); PG8_BAR; PG8_SCHED;
            PG8_LDB(B1, 0, 1); PG8_STAGE(PG8_SB(0, 0), b2, voffB);
            PG8_BAR; PG8_WAIT_L(0); PG8_MMA(0, 1, At, B1); PG8_BAR;
            PG8_LDA(At, 0, 1); PG8_STAGE(PG8_SA(0, 0), a2, voffA);
            PG8_BAR; PG8_WAIT_L(0); PG8_MMA(1, 0, At, B0); PG8_BAR; PG8_SCHED;
            PG8_STAGE(PG8_SB(0, 1), b2 + hstepB, voffB);
            PG8_WAIT_V(6); PG8_BAR; PG8_MMA(1, 1, At, B1); PG8_BAR;
            PG8_LDB(B0, 1, 0); PG8_SCHED; PG8_LDA(At, 1, 0); PG8_STAGE(PG8_SA(0, 1), a2 + hstep, voffA);
            PG8_WAIT_L(8); PG8_BAR; PG8_WAIT_L(0); PG8_MMA(0, 0, At, B0); PG8_BAR; PG8_SCHED;
            PG8_LDB(B1, 1, 1); PG8_STAGE(PG8_SB(1, 0), b3, voffB);
            PG8_BAR; PG8_WAIT_L(0); PG8_MMA(0, 1, At, B1); PG8_BAR;
            PG8_LDA(At, 1, 1); PG8_STAGE(PG8_SA(1, 0), a3, voffA);
            PG8_BAR; PG8_WAIT_L(0); PG8_MMA(1, 0, At, B0); PG8_BAR; PG8_SCHED;
            PG8_STAGE(PG8_SB(1, 1), b3 + hstepB, voffB);
            PG8_WAIT_V(6); PG8_BAR; PG8_MMA(1, 1, At, B1); PG8_BAR;
            }
        }
        if constexpr (ALIGN_EPI) { if (wr == 0) PG8_BAR; }
        if constexpr (!Epi::AFTER_DRAIN) { E(acc, cur, wr, wc, fr, fq, lds, tid); S.done(cur); }
        if (!has_next) break;
#pragma unroll
        for (int a = 0; a < 2; ++a)
#pragma unroll
            for (int b = 0; b < 2; ++b)
#pragma unroll
                for (int m = 0; m < 4; ++m)
#pragma unroll
                    for (int n = 0; n < 2; ++n) acc[a][b][m][n] = (f32x4){0.f, 0.f, 0.f, 0.f};
        cur = nxt; cA = nA; cB = nB; ++ui;
        if constexpr (ALIGN_EPI) { if (wr == 1) PG8_BAR; }
    }
    PG8_WAIT_V(0);
    if constexpr (!ALIGN_EPI) { if (wr == 0) PG8_BAR; }
    PG8_BAR;
    if constexpr (Epi::AFTER_DRAIN) { E.fused(acc, cur, wr, wc, fr, fq, lds, wid, lane); S.done(cur); }
#undef PG8_SA
#undef PG8_SB
#undef PG8_STAGE
#undef PG8_LDA
#undef PG8_LDB
#undef PG8_MMA
#undef PG8_WAIT_V
#undef PG8_WAIT_L
#undef PG8_BAR
#undef PG8_SCHED
}
}

constexpr int NWAVES = 8;
constexpr int BATCH = 16, SEQ = 2048, D = 1024, DEPTH = 4, T = BATCH * SEQ;
constexpr int P_IN = 2594, NPROJ = 2816, FF = 4096;
constexpr int C_Q = 0, C_KV = 384, C_GQ = 1152, C_GK = 1344, C_GV = 1536, C_OG = 1920, C_PU = 2304, C_GLR = 2560, C_GATE = 2576;
constexpr float LN_EPS = 1e-5f, RMS_EPS = 1e-6f;
constexpr float ALPHA = 1.6817928305074290f;
constexpr float QSCALE = 0.125f * 1.4426950408889634f;

constexpr size_t MiB = 1u << 20, KiB = 1u << 10;
constexpr size_t WS_CTL = 0, CTL_ZERO_BYTES = 1 * MiB;
constexpr size_t WS_CV = 3 * MiB;
constexpr size_t CV_C1IN = 0, CV_C2IN = 4 * 2816, CV_C1UP = 8 * 2816, CV_C2UP = 8 * 2816 + 4 * 4096;
constexpr size_t WS_ROPE = 4 * MiB;
constexpr size_t WS_BIAS1 = 4 * MiB + 128 * KiB;
constexpr size_t WS_W2G = 4 * MiB + 192 * KiB;
constexpr size_t WS_WP = 4 * MiB + 256 * KiB;
constexpr size_t WS_W2C = 4 * MiB + 384 * KiB;
constexpr size_t WS_GB = 4 * MiB + 448 * KiB;
constexpr size_t WS_W1C = 5 * MiB;
constexpr size_t WS_WIN = 7 * MiB;
constexpr size_t WS_WOUT = 29 * MiB;
constexpr size_t WS_WUP = 37 * MiB;
constexpr size_t WS_WDN = 69 * MiB;
constexpr size_t WS_KC = 101 * MiB;
constexpr size_t WS_VC = 101 * MiB + 512 * KiB;
constexpr size_t WS_DECAY = 102 * MiB;
constexpr size_t WS_DST = 103 * MiB;
constexpr size_t WS_XN = 127 * MiB;
constexpr size_t WS_R = 191 * MiB;
constexpr size_t WS_MIXED = WS_R + 22 * MiB, SLAB_PADP = 10 * MiB, SLAB_PADM = 24 * MiB;
constexpr size_t WS_ST = 447 * MiB;
constexpr size_t WS_VT = 455 * MiB;
constexpr size_t WS_QK = 471 * MiB;
constexpr size_t WS_CP = 495 * MiB;
constexpr size_t CP_UP = (size_t)3 * 2 * 16 * 2816;
constexpr size_t WS_END = 499 * MiB;
static_assert(WS_CV + (8 * 2816 + 8 * 4096) * 4 <= WS_ROPE && WS_WIN + (size_t)DEPTH * NPROJ * D * 2 <= WS_WOUT && WS_DST + (size_t)16 * 6 * 32 * 32 * 64 * 4 <= WS_XN && (size_t)4096 * NPROJ * 2 <= 22 * MiB && (size_t)4096 * D * 2 <= 8 * MiB && (size_t)4096 * FF * 2 == 32 * MiB && WS_R + 8 * 32 * MiB <= WS_ST && WS_ST + (size_t)2 * T * 32 * 4 <= WS_VT && WS_VT + (size_t)16 * 2 * 2 * 64 * 2048 * 2 <= WS_QK && WS_QK + (size_t)T * 384 * 2 <= WS_CP && WS_CP + (CP_UP + (size_t)4 * 2 * 16 * 4096) * 4 <= WS_END, "d_ws map");
constexpr int CW_BAR = 4096;

constexpr int SCR_BYTES = 143360;
constexpr int LDSCTL_OFF = SCR_BYTES;
constexpr int LDS_BYTES = 147456;

#define GAS __attribute__((address_space(1)))
#define LAS __attribute__((address_space(3)))
typedef unsigned short bf16;
typedef unsigned v4u __attribute__((ext_vector_type(4)));
typedef unsigned v2u __attribute__((ext_vector_type(2)));
typedef float f32x4 __attribute__((ext_vector_type(4)));
typedef float f32x16 __attribute__((ext_vector_type(16)));
typedef short bf16x8 __attribute__((ext_vector_type(8)));
#define LDS_WAIT() asm volatile("s_waitcnt lgkmcnt(0)" ::: "memory")
#define VM_WAIT() asm volatile("s_waitcnt vmcnt(0)" ::: "memory")
typedef float f32x2_t __attribute__((ext_vector_type(2))); typedef __bf16 bf16x2_t __attribute__((ext_vector_type(2)));
__device__ __forceinline__ unsigned pk2(float lo, float hi) { const f32x2_t v = {lo, hi}; const bf16x2_t b = __builtin_convertvector(v, bf16x2_t); return __builtin_bit_cast(unsigned, b); }
__device__ __forceinline__ unsigned f2bf(float f) { return pk2(f, 0.f) & 0xffffu; }
__device__ __forceinline__ float bf2f(unsigned b) { return __builtin_bit_cast(float, b << 16); }
__device__ __forceinline__ float bflo(unsigned w) { return __builtin_bit_cast(float, w << 16); }
__device__ __forceinline__ float bfhi(unsigned w) { return __builtin_bit_cast(float, w & 0xffff0000u); }
__device__ __forceinline__ f32x4 mma16(bf16x8 a, bf16x8 b, f32x4 c) { return __builtin_amdgcn_mfma_f32_16x16x32_bf16(a, b, c, 0, 0, 0); }
__device__ __forceinline__ f32x16 mma32(bf16x8 a, bf16x8 b, f32x16 c) { return __builtin_amdgcn_mfma_f32_32x32x16_bf16(a, b, c, 0, 0, 0); }
__device__ __forceinline__ float ex2(float x) { return __builtin_amdgcn_exp2f(x); }
__device__ __forceinline__ float fexp(float x) { return __builtin_amdgcn_exp2f(x * 1.4426950408889634f); }
__device__ __forceinline__ float sigmoidf_(float x) { return __builtin_amdgcn_rcpf(1.0f + fexp(-x)); }
__device__ __forceinline__ bf16x8 as_bf16x8(v4u v) { return __builtin_bit_cast(bf16x8, v); }
#define XB_TMO      128
#define XB_XCNT(j)  (256  + 64 * (j))
#define XB_XSUB(j)  (1280 + 64 * (j))
#define XB_XGEN(j)  (2304 + 64 * (j))
#define XB_TOP      3328
#define XB_TOPGEN   3392
#define XB_LSUB(j)  (3456 + 64 * (j))
#define XB_LGEN(j)  (4480 + 64 * (j))
#define XCD_BAR_WORDS 5504
#define XB_SPIN_CAP (1u << 18)

__device__ __forceinline__ unsigned xb_ld(unsigned* p)              { return __hip_atomic_load(p, __ATOMIC_RELAXED, __HIP_MEMORY_SCOPE_AGENT); }
__device__ __forceinline__ unsigned xb_add(unsigned* p, unsigned v) { return __hip_atomic_fetch_add(p, v, __ATOMIC_RELAXED, __HIP_MEMORY_SCOPE_AGENT); }
__device__ __forceinline__ unsigned xb_xcc_id() { return (unsigned)__builtin_amdgcn_s_getreg((3 << 11) | 20) & 0xFu; }
#define XB_SPIN(cond, bar) do { unsigned _sp = 0; while (cond) { __builtin_amdgcn_s_sleep(1); \
    if ((++_sp & 255u) == 0u) { if (xb_ld(&(bar)[XB_TMO])) break; if (_sp > XB_SPIN_CAP) { atomicAdd(&(bar)[XB_TMO], 1u); break; } } } } while (0)

struct XcdBarrier {
    unsigned* bar; unsigned x;
    volatile LAS unsigned* st;
};

__device__ __forceinline__ XcdBarrier xcd_barrier_post(unsigned* bar, volatile LAS unsigned* st) {
    XcdBarrier b; b.bar = bar; b.x = xb_xcc_id(); b.st = st;
    if (threadIdx.x == 0) st[2] = xb_add(&bar[XB_XCNT(b.x)], 1u);
    return b;
}
__device__ __forceinline__ void xcd_barrier_complete(unsigned* bar, unsigned x, unsigned& nloc, unsigned& nx) {
    const unsigned G = gridDim.x * gridDim.y * gridDim.z;
    unsigned sum, cnt, mine, sp = 0u;
    for (;;) {
        sum = 0u; cnt = 0u; mine = 0u;
#pragma unroll
        for (unsigned j = 0; j < 16; ++j) { const unsigned c = xb_ld(&bar[XB_XCNT(j)]); sum += c; cnt += (c > 0u) ? 1u : 0u; mine = (j == x) ? c : mine; }
        if (sum == G) break;
        __builtin_amdgcn_s_sleep(1);
        if ((++sp & 255u) == 0u) { if (xb_ld(&bar[XB_TMO])) break; if (sp > XB_SPIN_CAP) { atomicAdd(&bar[XB_TMO], 1u); break; } }
    }
    nloc = mine > 0u ? mine : 1u; nx = cnt > 0u ? cnt : 1u;
}

__device__ __forceinline__ void xcd_barrier(const XcdBarrier& b, const bool leader_thread  ) {
    asm volatile("s_waitcnt vmcnt(0)" ::: "memory");
    __syncthreads();
    if (leader_thread) {
        unsigned* bar = b.bar;
        __builtin_amdgcn_s_waitcnt(0);
        unsigned nloc = b.st[0], nx = b.st[1];
        if (nloc == 0u) { xcd_barrier_complete(bar, b.x, nloc, nx); b.st[0] = nloc; b.st[1] = nx; }
        const unsigned old = xb_add(&bar[XB_XSUB(b.x)], 1u);
        const unsigned gen = old / nloc;
        if (old + 1u == (gen + 1u) * nloc) {
            __builtin_amdgcn_fence(__ATOMIC_RELEASE, "agent");
            asm volatile("s_waitcnt vmcnt(0)" ::: "memory");
            const unsigned og = xb_add(&bar[XB_TOP], 1u);
            const unsigned tg = og / nx;
            if (og + 1u == (tg + 1u) * nx) xb_add(&bar[XB_TOPGEN], 1u);
            else XB_SPIN(xb_ld(&bar[XB_TOPGEN]) == tg, bar);
            __builtin_amdgcn_fence(__ATOMIC_ACQUIRE, "agent");
            xb_add(&bar[XB_XGEN(b.x)], 1u);
            asm volatile("s_waitcnt vmcnt(0)" ::: "memory");
        } else {
            XB_SPIN(xb_ld(&bar[XB_XGEN(b.x)]) == gen, bar);
            __builtin_amdgcn_fence(__ATOMIC_ACQUIRE, "agent");
            asm volatile("s_waitcnt vmcnt(0)" ::: "memory");
        }
    }
    __syncthreads();
}

__device__ __forceinline__ void xcd_barrier_local(const XcdBarrier& b, const bool leader_thread) {
    asm volatile("s_waitcnt vmcnt(0)" ::: "memory");
    __syncthreads();
    if (leader_thread) {
        unsigned* bar = b.bar;
        __builtin_amdgcn_s_waitcnt(0);
        const unsigned nloc = b.st[0];
        const unsigned old = xb_add(&bar[XB_LSUB(b.x)], 1u);
        const unsigned gen = old / nloc;
        if (old + 1u == (gen + 1u) * nloc) {
            __builtin_amdgcn_fence(__ATOMIC_RELEASE, "agent");
            asm volatile("s_waitcnt vmcnt(0)" ::: "memory");
            xb_add(&bar[XB_LGEN(b.x)], 1u);
            __builtin_amdgcn_fence(__ATOMIC_ACQUIRE, "agent");
            asm volatile("s_waitcnt vmcnt(0)" ::: "memory");
        } else {
            XB_SPIN(xb_ld(&bar[XB_LGEN(b.x)]) == gen, bar);
            __builtin_amdgcn_fence(__ATOMIC_ACQUIRE, "agent");
            asm volatile("s_waitcnt vmcnt(0)" ::: "memory");
        }
    }
    __syncthreads();
}
__device__ __forceinline__ int xcd_local_id(const XcdBarrier& b, unsigned G) {
    unsigned nx = 0u, xidx = 0u; bool even = (G == 256u);
#pragma unroll
    for (unsigned j = 0; j < 16; ++j) { const unsigned c = xb_ld(&b.bar[XB_XCNT(j)]); if (c) { if (c != 32u) even = false; if (j < b.x) ++xidx; ++nx; } }
    const unsigned rank = b.st[2];
    return (even && nx == 8u && rank < 32u) ? (int)(rank * 8u + xidx) : -1;
}

struct Frame { LAS unsigned char* lds; int tid, lane, wave, G, bid, wave0, cid, lok; };
#define FRAME_REFRESH(F) do { int w_ = (F).wave0; asm volatile("" : "+s"(w_)); unsigned m_ = ~0u; asm volatile("" : "+s"(m_)); int l_ = (int)__builtin_amdgcn_mbcnt_hi(m_, __builtin_amdgcn_mbcnt_lo(m_, 0u)); asm volatile("" : "+v"(l_)); int b_ = (F).cid; asm volatile("" : "+s"(b_)); (F).tid = w_ * 64 + l_; (F).lane = l_; (F).wave = w_; (F).bid = b_; } while (0)
struct Args { const float* in[17]; float* out; unsigned char* ws; int ph_lo, ph_hi; };
static_assert(sizeof(Args) == 19 * 8 + 8, "Args has no padding");
__device__ __forceinline__ const unsigned char* karg_ptr(int idx) {
    unsigned long long base = (unsigned long long)__builtin_amdgcn_kernarg_segment_ptr();
    asm volatile("" : "+s"(base));
    const unsigned long long v = ((const __attribute__((address_space(4))) unsigned long long*)base)[idx];
    return (const unsigned char*)(const __attribute__((address_space(1))) unsigned char*)v;
}
#define P_IN_(i) ((const float*)karg_ptr(i))
#define P_x P_IN_(0)
#define P_w_in P_IN_(1)
#define P_cmp_pos P_IN_(2)
#define P_cmp_w1 P_IN_(3)
#define P_cmp_w2 P_IN_(4)
#define P_gla_w2 P_IN_(5)
#define P_gla_b P_IN_(6)
#define P_gla_ng P_IN_(7)
#define P_pool_w P_IN_(8)
#define P_pool_s P_IN_(9)
#define P_w_out P_IN_(10)
#define P_ln1_g P_IN_(11)
#define P_ln1_b P_IN_(12)
#define P_w_up P_IN_(13)
#define P_w_down P_IN_(14)
#define P_ln2_g P_IN_(15)
#define P_ln2_b P_IN_(16)
#define P_H ((float*)karg_ptr(17))
#define P_WS ((unsigned char*)karg_ptr(18))
#define P_rope ((float*)(P_WS + WS_ROPE))
#define P_bias1 ((float*)(P_WS + WS_BIAS1))
#define P_decay ((float*)(P_WS + WS_DECAY))
#define P_dst ((float*)(P_WS + WS_DST))
#define P_W2G ((bf16*)(P_WS + WS_W2G))
#define P_WP ((bf16*)(P_WS + WS_WP))
#define P_W2C ((bf16*)(P_WS + WS_W2C))
#define P_W1C ((bf16*)(P_WS + WS_W1C))
#define P_WIN ((bf16*)(P_WS + WS_WIN))
#define P_WOUT ((bf16*)(P_WS + WS_WOUT))
#define P_WUP ((bf16*)(P_WS + WS_WUP))
#define P_WDN ((bf16*)(P_WS + WS_WDN))
#define P_KC ((bf16*)(P_WS + WS_KC))
#define P_VC ((bf16*)(P_WS + WS_VC))
#define P_XN ((bf16*)(P_WS + WS_XN))
#define P_VT ((bf16*)(P_WS + WS_VT))
#define P_QK ((bf16*)(P_WS + WS_QK))
#define P_CP ((float*)(P_WS + WS_CP))
#define P_PROJ ((bf16*)(P_WS + WS_R))
#define P_MIXED ((bf16*)(P_WS + WS_MIXED))
#define P_U ((bf16*)(P_WS + WS_R))
#define P_PROJ_B(b) ((bf16*)(P_WS + WS_R + (size_t)((b) >> 1) * SLAB_PADP))
#define P_MIXED_B(b) ((bf16*)(P_WS + WS_MIXED + (size_t)((b) >> 1) * SLAB_PADM))
#define P_ST(k) ((float*)(P_WS + WS_ST) + (size_t)((k) & 1) * T * 8)
#define P_CV ((float*)(P_WS + WS_CV))
#define P_GB ((float*)(P_WS + WS_GB))
__device__ __forceinline__ float wave_sum(float v, int lane) {
#pragma unroll
    for (int o = 1; o < 64; o <<= 1) v += shx(v, o, lane);
    return v;
}

__device__ __forceinline__ int inproj_src_col(int n) {
    if (n < 1152) return n;
    if (n < 1920) return n + 18;
    if (n < 2560) return n + 34;
    if (n < 2576) return 1938 + (n - 2560);
    if (n < 2594) return 1152 + (n - 2576);
    return -1;
}
template <bool MAPIN, bool FOLD>
__device__ __forceinline__ void transpose_item(const float* W, int K, int Nsrc, bf16* WT, LAS float* scr, int kb, int nb, int lane, const float* gam = nullptr, const float* bet = nullptr, float* cp1 = nullptr, float* cp2 = nullptr) {
    typedef float f32x2t __attribute__((ext_vector_type(2)));
    const int k0 = 64 * kb, n0 = 64 * nb, cp = lane & 31, kh = lane >> 5;
    int sc = n0 + 2 * cp; if (MAPIN) sc = inproj_src_col(sc);
    f32x2t a1 = (f32x2t){0.f, 0.f}, a2 = a1;
#pragma unroll 1
    for (int hb = 0; hb < 2; ++hb) {
        f32x2t wv[16]; float gg[FOLD ? 16 : 1], bb[FOLD ? 16 : 1];
#pragma unroll
        for (int i = 0; i < 16; ++i) { const int kk = 2 * (16 * hb + i) + kh; wv[i] = (f32x2t){0.f, 0.f};
            if (sc >= 0) wv[i] = *(const f32x2t*)(W + (size_t)(k0 + kk) * Nsrc + sc);
            if (FOLD) { gg[i] = gam[k0 + kk]; bb[i] = bet[k0 + kk]; } }
#pragma unroll
        for (int i = 0; i < 16; ++i) { const int kk = 2 * (16 * hb + i) + kh; f32x2t w = wv[i];
            if (FOLD) { a2 = a2 + w * bb[i]; w = w * gg[i]; a1[0] += bf2f(f2bf(w[0])); a1[1] += bf2f(f2bf(w[1])); }
            scr[kk * 65 + 2 * cp] = w[0]; scr[kk * 65 + 2 * cp + 1] = w[1]; }
    }
    if (FOLD) { a1[0] += shx(a1[0], 32, lane); a1[1] += shx(a1[1], 32, lane); a2[0] += shx(a2[0], 32, lane); a2[1] += shx(a2[1], 32, lane);
        if (kh == 0) { *(f32x2t*)(cp1 + n0 + 2 * cp) = a1; *(f32x2t*)(cp2 + n0 + 2 * cp) = a2; } }
    LDS_WAIT(); asm volatile("" ::: "memory");
    const int c = lane & 7;
#pragma unroll
    for (int j = 0; j < 8; ++j) { const int n = (lane >> 3) + 8 * j; const LAS float* s = scr + (8 * c) * 65 + n;
        v4u o; o.x = pk2(s[0 * 65], s[1 * 65]); o.y = pk2(s[2 * 65], s[3 * 65]); o.z = pk2(s[4 * 65], s[5 * 65]); o.w = pk2(s[6 * 65], s[7 * 65]);
        *(v4u*)(WT + (size_t)(n0 + n) * K + k0 + 8 * c) = o; }
    LDS_WAIT(); asm volatile("" ::: "memory");
}

__device__ __forceinline__ void p0_prologue(Frame& F) {
    LAS float* scr = (LAS float*)(F.lds + F.wave * 16640);
    const int gw = F.bid * NWAVES + F.wave, NGW = F.G * NWAVES;
    constexpr int I_IN = (D / 64) * (NPROJ / 64), I_OUT = (D / 64) * (D / 64), I_UP = (D / 64) * (FF / 64), I_DN = (FF / 64) * (D / 64), I_C1 = 2 * 32, I_C2 = 2, I_WP = 4;
    constexpr int I_LAYER = I_IN + I_OUT + I_UP + I_DN + I_C1 + I_C2 + I_WP;
    for (int it = gw; it < DEPTH * I_LAYER; it += NGW) {
        const int l = it / I_LAYER; int r = it % I_LAYER;
        if (r < I_IN) { if (l == 0) transpose_item<true, false>(P_w_in, D, P_IN, P_WIN, scr, r / (NPROJ / 64), r % (NPROJ / 64), F.lane);
                         else transpose_item<true, true>(P_w_in + (size_t)l * D * P_IN, D, P_IN, P_WIN + (size_t)l * NPROJ * D, scr, r / (NPROJ / 64), r % (NPROJ / 64), F.lane, P_ln2_g + (l - 1) * D, P_ln2_b + (l - 1) * D,
                                                        P_CP + ((size_t)((l - 1) * 2 + 0) * 16 + r / (NPROJ / 64)) * NPROJ, P_CP + ((size_t)((l - 1) * 2 + 1) * 16 + r / (NPROJ / 64)) * NPROJ);
                         continue; } r -= I_IN;
        if (r < I_OUT) { transpose_item<false, false>(P_w_out + (size_t)l * D * D, D, D, P_WOUT + (size_t)l * D * D, scr, r / (D / 64), r % (D / 64), F.lane); continue; } r -= I_OUT;
        if (r < I_UP) { transpose_item<false, true>(P_w_up + (size_t)l * D * FF, D, FF, P_WUP + (size_t)l * D * FF, scr, r / (FF / 64), r % (FF / 64), F.lane, P_ln1_g + l * D, P_ln1_b + l * D,
                                                      P_CP + CP_UP + ((size_t)(l * 2 + 0) * 16 + r / (FF / 64)) * FF, P_CP + CP_UP + ((size_t)(l * 2 + 1) * 16 + r / (FF / 64)) * FF); continue; } r -= I_UP;
        if (r < I_DN) { transpose_item<false, false>(P_w_down + (size_t)l * D * FF, FF, D, P_WDN + (size_t)l * D * FF, scr, r / (D / 64), r % (D / 64), F.lane); continue; } r -= I_DN;
        if (r < I_C1) { const int kv = r / 32, rr = r % 32; transpose_item<false, false>(P_cmp_w1 + (size_t)(l * 2 + kv) * 2048 * 64, 2048, 64, P_W1C + (size_t)(l * 2 + kv) * 64 * 2048, scr, rr, 0, F.lane); continue; } r -= I_C1;
        if (r < I_C2) { const int kv = r; transpose_item<false, false>(P_cmp_w2 + (size_t)(l * 2 + kv) * 64 * 64, 64, 64, P_W2C + (size_t)(l * 2 + kv) * 64 * 64, scr, 0, 0, F.lane); continue; } r -= I_C2;
        { const int g = r; transpose_item<false, false>(P_pool_w + (size_t)(l * 4 + g) * 64 * 64, 64, 64, P_WP + (size_t)(l * 4 + g) * 64 * 64, scr, 0, 0, F.lane); }
    }
    for (int task = F.bid + F.G * F.wave; task < DEPTH * 2 * 64; task += NGW) {
        const int lk = task >> 6, j = task & 63; const float* pp = P_cmp_pos + (size_t)lk * 2048; const float* ww = P_cmp_w1 + (size_t)lk * 2048 * 64 + j;
        float s = 0.f;
#pragma unroll 1
        for (int k0 = F.lane; k0 < 2048; k0 += 512) { float pv[8], wv[8];
#pragma unroll
            for (int i = 0; i < 8; ++i) { pv[i] = pp[k0 + 64 * i]; wv[i] = ww[(size_t)(k0 + 64 * i) * 64]; }
#pragma unroll
            for (int i = 0; i < 8; ++i) s += pv[i] * wv[i]; }
        s = wave_sum(s, F.lane);
        if (F.lane == 0) P_bias1[task] = s;
    }
    const int gt = F.bid * (NWAVES * 64) + F.tid, NGT = F.G * NWAVES * 64;
    float* const ropep = P_rope;
    for (int idx = gt; idx < SEQ * 8; idx += NGT) {
        const int pos = idx >> 3, i = idx & 7;
        const float inv = (i == 0) ? 1.0f : (i == 1) ? 0.1939227432012558f : (i == 2) ? 0.03760603070259094f : (i == 3) ? 0.007292664609849453f : (i == 4) ? 0.0014142135623842478f
                        : (i == 5) ? 0.00027424818836152554f : (i == 6) ? 5.318296098266728e-05f : 1.0313386155758053e-05f;
        const float ang = (float)pos * inv;
        double rev = (double)ang * 0.15915494309189535; rev -= __builtin_floor(rev);
        const float rf = (float)rev;
        ropep[pos * 16 + i] = __builtin_amdgcn_cosf(rf); ropep[pos * 16 + 8 + i] = __builtin_amdgcn_sinf(rf);
    }
    for (int idx = gt; idx < 8 * 2048; idx += NGT) { const int k = idx >> 11, c = idx & 1023, isb = (idx >> 10) & 1, l = k >> 1;
        const float* src = (k & 1) ? (isb ? P_ln2_b : P_ln2_g) : (isb ? P_ln1_b : P_ln1_g); P_GB[idx] = src[l * D + c]; }
    { bf16* const w2g = P_W2G; const float* const gw2 = P_gla_w2;
    for (int idx = gt; idx < DEPTH * 192 * 32; idx += NGT) {
        const int k = idx & 31, col = (idx >> 5) % 192, l = idx / (192 * 32);
        w2g[idx] = (k < 16) ? (bf16)f2bf(gw2[(size_t)(l * 16 + k) * 192 + col]) : (bf16)0;
    } }
    { const float* const xin = P_x; bf16* const xn = P_XN;
    const size_t step = (size_t)NGT * 8;
    for (size_t i = (size_t)gt * 8; i < (size_t)T * D; i += 4 * step) {
        f32x4 a[4], b[4];
#pragma unroll
        for (int k = 0; k < 4; ++k) if (i + k * step < (size_t)T * D) { a[k] = *(const f32x4*)(xin + i + k * step); b[k] = *(const f32x4*)(xin + i + k * step + 4); }
#pragma unroll
        for (int k = 0; k < 4; ++k) if (i + k * step < (size_t)T * D) { v4u o; o.x = pk2(a[k][0], a[k][1]); o.y = pk2(a[k][2], a[k][3]); o.z = pk2(b[k][0], b[k][1]); o.w = pk2(b[k][2], b[k][3]);
            *(v4u*)(xn + i + k * step) = o; }
    } }
}

__device__ __forceinline__ void fold_vectors_reduce(Frame& F) {
    const float* const cpb = P_CP; float* const cv = P_CV;
    const int gt = F.bid * (NWAVES * 64) + F.tid, NGT = F.G * NWAVES * 64;
    constexpr int N_IN = 3 * 2 * NPROJ, N_UP = 4 * 2 * FF;
    for (int idx = gt; idx < N_IN + N_UP; idx += NGT) {
        const bool isup = idx >= N_IN; const int e = isup ? idx - N_IN : idx, N = isup ? FF : NPROJ;
        const int lw = e / N, n = e % N, which = lw & 1, l = isup ? (lw >> 1) : 1 + (lw >> 1);
        const float* p = cpb + (isup ? CP_UP : 0) + (size_t)lw * 16 * N + n;
        float s = 0.f;
#pragma unroll
        for (int kb = 0; kb < 16; ++kb) s += p[(size_t)kb * N];
        cv[(isup ? (which ? CV_C2UP : CV_C1UP) + (size_t)l * FF : (which ? CV_C2IN : CV_C1IN) + (size_t)l * NPROJ) + n] = s;
    }
}
__device__ __forceinline__ void final_ln_phase(Frame& F, const float* st, const float* gam, const float* bet) {
    float* const Hp = P_H; const bf16* const XNp = P_XN;
    const int gw = F.bid * NWAVES + F.wave, NGW = F.G * NWAVES;
    f32x4 gv[4], bv[4];
#pragma unroll
    for (int j = 0; j < 4; ++j) { gv[j] = *(const f32x4*)(gam + 4 * F.lane + 256 * j); bv[j] = *(const f32x4*)(bet + 4 * F.lane + 256 * j); }
    v2u w[4], wn[4]; float sv, svn;
#define FLN_REQ(m_, W_, S_) do { const bf16* xr_ = XNp + (size_t)(m_) * D + 4 * F.lane; S_ = (F.lane < 8) ? st[(size_t)(m_) * 8 + F.lane] : 0.f; \
        _Pragma("unroll") for (int j = 0; j < 4; ++j) W_[j] = *(const v2u*)(xr_ + 256 * j); } while (0)
    if (gw < T) FLN_REQ(gw, w, sv);
    for (int m = gw; m < T; m += NGW) {
        const bool more = m + NGW < T;
        if (more) FLN_REQ(m + NGW, wn, svn);
        float* hr = Hp + (size_t)m * D + 4 * F.lane;
        sv += shx(sv, 2, F.lane); sv += shx(sv, 4, F.lane);
        const float s0 = __builtin_bit_cast(float, __builtin_amdgcn_readlane(__builtin_bit_cast(int, sv), 0)), s1 = __builtin_bit_cast(float, __builtin_amdgcn_readlane(__builtin_bit_cast(int, sv), 1));
        const float mu = s0 * (1.0f / 1024.0f), rstd = 1.0f / sqrtf(fmaxf(s1 * (1.0f / 1024.0f) - mu * mu, 0.f) + LN_EPS);
#pragma unroll
        for (int j = 0; j < 4; ++j) { f32x4 v; v[0] = bflo(w[j].x); v[1] = bfhi(w[j].x); v[2] = bflo(w[j].y); v[3] = bfhi(w[j].y); *(f32x4*)(hr + 256 * j) = (v - mu) * rstd * gv[j] + bv[j]; }
        if (more) { sv = svn;
#pragma unroll
            for (int j = 0; j < 4; ++j) w[j] = wn[j]; }
    }
#undef FLN_REQ
}

__device__ __forceinline__ void m1_compress(Frame& F, int l, int unit) {
    const bf16* const W1C = P_W1C; const bf16* const W2C = P_W2C; const float* const bias1 = P_bias1; bf16* const KC = P_KC; bf16* const VC = P_VC;
    const int rb = unit & 3, kv = (unit >> 2) & 1, g = (unit >> 3) & 1, b = unit >> 4;
    const bf16* const PROJ = P_PROJ_B(b);
    LAS bf16* Ts = (LAS bf16*)F.lds;
    LAS bf16* Hs = Ts + 528 * 72;
    const int colsrc = C_KV + ((0 * 2 + kv) * 2 + g) * 64, tok0 = 512 * rb;
    for (int c = F.tid; c < 528 * 8; c += NWAVES * 64) {
        const int r = c >> 3, ch = c & 7, tok = tok0 + r; v4u v = (v4u){0u, 0u, 0u, 0u};
        if (tok < SEQ) v = *(const v4u*)(PROJ + (size_t)(b * SEQ + tok) * NPROJ + colsrc + 8 * ch);
        *(LAS v4u*)(Ts + r * 72 + 8 * ch) = v;
    }
    __syncthreads();
    const int mt = F.wave >> 2, nt = F.wave & 3, fr = F.lane & 15, fq = F.lane >> 4;
    const int lk = l * 2 + kv;
    {
        const bf16* w1t = W1C + ((size_t)lk * 64 + 16 * nt + fr) * 2048 + 8 * fq;
        const LAS bf16* ap = Ts + (16 * (16 * mt + fr)) * 72;
        f32x4 acc = (f32x4){0.f, 0.f, 0.f, 0.f};
#pragma unroll 8
        for (int kk = 0; kk < 64; ++kk) { const int k0 = 32 * kk + 8 * fq;
            const bf16x8 a = *(const LAS bf16x8*)(ap + (k0 >> 6) * 72 + (k0 & 63));
            const bf16x8 w = *(const bf16x8*)(w1t + 32 * kk);
            acc = mma16(a, w, acc); }
        const float bias = bias1[lk * 64 + 16 * nt + fr];
#pragma unroll
        for (int r = 0; r < 4; ++r) { const float xv = acc[r] + bias;
            const float u = 0.7978845608028654f * (xv + 0.044715f * xv * xv * xv);
            const float th = 1.0f - 2.0f * __builtin_amdgcn_rcpf(1.0f + fexp(2.0f * u));
            const float gl = 0.5f * xv * (1.0f + th);
            Hs[(16 * mt + 4 * fq + r) * 72 + 16 * nt + fr] = (bf16)f2bf(gl); }
    }
    __syncthreads();
    {
        const bf16* w2t = W2C + ((size_t)lk * 64 + 16 * nt + fr) * 64 + 8 * fq;
        f32x4 acc = (f32x4){0.f, 0.f, 0.f, 0.f};
#pragma unroll
        for (int kk = 0; kk < 2; ++kk) { const bf16x8 a = *(const LAS bf16x8*)(Hs + (16 * mt + fr) * 72 + 32 * kk + 8 * fq); const bf16x8 w = *(const bf16x8*)(w2t + 32 * kk); acc = mma16(a, w, acc); }
        const int n0 = 32 * rb + 16 * mt + 4 * fq;
        if (kv == 0) { bf16* dstp = KC + (size_t)(b * 2 + g) * 128 * 64;
#pragma unroll
            for (int r = 0; r < 4; ++r) dstp[(n0 + r) * 64 + 16 * nt + fr] = (n0 + r < 127) ? (bf16)f2bf(acc[r]) : (bf16)0;
        } else {
            v2u w; w.x = pk2(acc[0], acc[1]); w.y = pk2(acc[2], (n0 + 3 < 127) ? acc[3] : 0.f);
            *(v2u*)(VC + ((size_t)(b * 2 + g) * 64 + 16 * nt + fr) * 128 + n0) = w; }
    }
    __syncthreads();
}

__device__ __forceinline__ void m1_vt(Frame& F, int unit) {
    bf16* const VT = P_VT;
    const int chunk = unit & 7, g = (unit >> 3) & 1, brm = (unit >> 4) & 1, b = unit >> 5;
    const bf16* const PROJ = P_PROJ_B(b);
    LAS bf16* Ls = (LAS bf16*)F.lds;
    const int colV = C_KV + (((1 + brm) * 2 + 1) * 2 + g) * 64 + 8 * F.wave;
#pragma unroll
    for (int i = 0; i < 4; ++i) { const int r = F.lane + 64 * i;
        const v4u vv = *(const v4u*)(PROJ + ((size_t)b * SEQ + 256 * chunk + r) * NPROJ + colV);
        LAS bf16* vp = Ls + (8 * F.wave) * 264 + r;
        vp[0 * 264] = (bf16)(vv.x & 0xffffu); vp[1 * 264] = (bf16)(vv.x >> 16); vp[2 * 264] = (bf16)(vv.y & 0xffffu); vp[3 * 264] = (bf16)(vv.y >> 16);
        vp[4 * 264] = (bf16)(vv.z & 0xffffu); vp[5 * 264] = (bf16)(vv.z >> 16); vp[6 * 264] = (bf16)(vv.w & 0xffffu); vp[7 * 264] = (bf16)(vv.w >> 16); }
    __syncthreads();
#pragma unroll
    for (int i = 0; i < 4; ++i) { const int idx = F.tid + 512 * i, d = idx >> 5, c = idx & 31;
        *(v4u*)(VT + ((size_t)((b * 2 + brm) * 2 + g) * 64 + d) * SEQ + 256 * chunk + 8 * c) = *(const LAS v4u*)(Ls + d * 264 + 8 * c); }
    __syncthreads();
}

__device__ __forceinline__ void m1_gla_pool(Frame& F, int l, int unit) {
    bf16* const QK = P_QK; const bf16* const W2G = P_W2G; const float* const gla_b = P_gla_b; float* const decay = P_decay; float* const dst = P_dst; const bf16* const WP = P_WP; const float* const pool_s = P_pool_s;
    const int b = unit >> 5, n = unit & 31; const bf16* const PROJ = P_PROJ_B(b); bf16* const MIXED = P_MIXED_B(b); const size_t row0 = (size_t)b * SEQ + 64 * n;
    const int fr = F.lane & 15, fq = F.lane >> 4;
    LAS float* BC = (LAS float*)F.lds;
    LAS bf16* KeT = (LAS bf16*)(F.lds + 49152);
    LAS bf16* VT = (LAS bf16*)(F.lds + 49152 + 27648);
    v4u qreg[3], kreg[3], vreg[6], ureg[5];
#pragma unroll
    for (int i = 0; i < 3; ++i) { const int idx = F.tid + 512 * i, c = idx / 24, col0 = 8 * (idx % 24);
        qreg[i] = *(const v4u*)(PROJ + (row0 + c) * NPROJ + C_GQ + col0); kreg[i] = *(const v4u*)(PROJ + (row0 + c) * NPROJ + C_GK + col0); }
#pragma unroll
    for (int i = 0; i < 6; ++i) { const int idx = F.tid + 512 * i, c = idx / 48, ch = idx % 48; vreg[i] = *(const v4u*)(PROJ + (row0 + c) * NPROJ + C_GV + 8 * ch); }
#pragma unroll
    for (int i = 0; i < 5; ++i) { const int idx = F.tid + 512 * i, r = idx >> 5, ch = idx & 31, sp = 64 * n + r - 15; ureg[i] = (v4u){0u, 0u, 0u, 0u};
        if (idx < 79 * 32 && sp >= 0) ureg[i] = *(const v4u*)(PROJ + ((size_t)b * SEQ + sp) * NPROJ + C_PU + 8 * ch); }
    __builtin_amdgcn_sched_barrier(0);
#pragma unroll
    for (int hb = 0; hb < 2; ++hb) {
    v4u zav[3], zbv[3]; float zbias[3];
#pragma unroll
    for (int i = 0; i < 3; ++i) { const int id = F.wave + NWAVES * (3 * hb + i), mt = id & 3, nt = id >> 2;
        zav[i] = (v4u){0u, 0u, 0u, 0u};
        if (fq < 2) zav[i] = *(const v4u*)(PROJ + (row0 + 16 * mt + fr) * NPROJ + C_GLR + 8 * fq);
        zbv[i] = *(const v4u*)(W2G + ((size_t)l * 192 + 16 * nt + fr) * 32 + 8 * fq);
        zbias[i] = gla_b[l * 192 + 16 * nt + fr]; }
#pragma unroll
    for (int i = 0; i < 3; ++i) { const int id = F.wave + NWAVES * (3 * hb + i);
        const int mt = id & 3, nt = id >> 2;
        const f32x4 z = mma16(as_bf16x8(zav[i]), as_bf16x8(zbv[i]), (f32x4){0.f, 0.f, 0.f, 0.f});
        const float bias = zbias[i];
#pragma unroll
        for (int r = 0; r < 4; ++r) { const float zz = z[r] + bias;
            const float ls = fminf(zz, 0.f) - __logf(1.0f + fexp(-fabsf(zz)));
            BC[(16 * mt + 4 * fq + r) * 192 + 16 * nt + fr] = ls * (1.0f / 16.0f); }
    }
    }
#pragma unroll
    for (int i = 0; i < 6; ++i) { const int idx = F.tid + 512 * i, c = idx / 48, ch = idx % 48; const v4u vv = vreg[i];
        LAS bf16* vp = VT + (8 * ch) * 72 + c;
        vp[0 * 72] = (bf16)(vv.x & 0xffffu); vp[1 * 72] = (bf16)(vv.x >> 16); vp[2 * 72] = (bf16)(vv.y & 0xffffu); vp[3 * 72] = (bf16)(vv.y >> 16);
        vp[4 * 72] = (bf16)(vv.z & 0xffffu); vp[5 * 72] = (bf16)(vv.z >> 16); vp[6 * 72] = (bf16)(vv.w & 0xffffu); vp[7 * 72] = (bf16)(vv.w >> 16); }
    __syncthreads();
    if (F.tid < 192) { float run = 0.f;
#pragma unroll 8
        for (int c = 0; c < 64; ++c) { run += BC[c * 192 + F.tid]; BC[c * 192 + F.tid] = run; } }
    __syncthreads();
#pragma unroll
    for (int i = 0; i < 3; ++i) { const int idx = F.tid + 512 * i, c = idx / 24, col0 = 8 * (idx % 24);
        const v4u qv = qreg[i], kvv = kreg[i];
        float bc[8], bl[8], qf[8], kf[8];
#pragma unroll
        for (int e = 0; e < 8; ++e) { bc[e] = BC[c * 192 + col0 + e]; bl[e] = BC[63 * 192 + col0 + e]; }
        qf[0] = bflo(qv.x); qf[1] = bfhi(qv.x); qf[2] = bflo(qv.y); qf[3] = bfhi(qv.y); qf[4] = bflo(qv.z); qf[5] = bfhi(qv.z); qf[6] = bflo(qv.w); qf[7] = bfhi(qv.w);
        kf[0] = bflo(kvv.x); kf[1] = bfhi(kvv.x); kf[2] = bflo(kvv.y); kf[3] = bfhi(kvv.y); kf[4] = bflo(kvv.z); kf[5] = bfhi(kvv.z); kf[6] = bflo(kvv.w); kf[7] = bfhi(kvv.w);
        float qd[8], ki[8];
#pragma unroll
        for (int e = 0; e < 8; ++e) { qd[e] = qf[e] * 0.17677669529663687f * fexp(bc[e]); ki[e] = kf[e] * fexp(-bc[e]);
            KeT[(col0 + e) * 72 + c] = (bf16)f2bf(kf[e] * fexp(bl[e] - bc[e])); }
        v4u qo, ko; qo.x = pk2(qd[0], qd[1]); qo.y = pk2(qd[2], qd[3]); qo.z = pk2(qd[4], qd[5]); qo.w = pk2(qd[6], qd[7]);
        ko.x = pk2(ki[0], ki[1]); ko.y = pk2(ki[2], ki[3]); ko.z = pk2(ki[4], ki[5]); ko.w = pk2(ki[6], ki[7]);
        *(v4u*)(QK + (row0 + c) * 384 + col0) = qo; *(v4u*)(QK + (row0 + c) * 384 + 192 + col0) = ko;
    }
    if (F.tid < 192) { const int h = F.tid >> 5, dk = F.tid & 31; decay[(((size_t)b * 6 + h) * 32 + n) * 32 + dk] = fexp(BC[63 * 192 + F.tid]); }
    __syncthreads();
    for (int id = F.wave; id < 48; id += NWAVES) {
        const int h = id >> 3, mt = (id >> 2) & 1, nt = id & 3;
        f32x4 acc = (f32x4){0.f, 0.f, 0.f, 0.f};
#pragma unroll
        for (int kk = 0; kk < 2; ++kk) { const bf16x8 a = *(const LAS bf16x8*)(KeT + (h * 32 + 16 * mt + fr) * 72 + 32 * kk + 8 * fq);
            const bf16x8 w = *(const LAS bf16x8*)(VT + (h * 64 + 16 * nt + fr) * 72 + 32 * kk + 8 * fq); acc = mma16(w, a, acc); }
        *(f32x4*)(dst + ((((size_t)b * 6 + h) * 32 + n) * 32 + 16 * mt + fr) * 64 + 16 * nt + 4 * fq) = acc;
    }
    __syncthreads();
    LAS bf16* Us = (LAS bf16*)F.lds;
    LAS bf16* Ps = (LAS bf16*)(F.lds + 45056);
#pragma unroll
    for (int i = 0; i < 5; ++i) { const int idx = F.tid + 512 * i, r = idx >> 5, ch = idx & 31; if (idx < 79 * 32) *(LAS v4u*)(Us + r * 264 + 8 * ch) = ureg[i]; }
    __syncthreads();
    {
        const int c = F.tid & 255, th = F.tid >> 8, w = 2 << (c >> 6), t0 = 32 * th;
        float s = 0.f;
        for (int tau = 0; tau < w; ++tau) s += bf2f(Us[(15 + t0 - tau) * 264 + c]);
#pragma unroll 4
        for (int t = t0; t < t0 + 32; ++t) {
            const float ut = bf2f(Us[(15 + t) * 264 + c]);
            if (t > t0) s += ut - bf2f(Us[(15 + t - w) * 264 + c]);
            const int sp = 64 * n + t; const int cnt = (sp + 1 < w) ? sp + 1 : w;
            Ps[t * 264 + c] = (bf16)f2bf(s * __builtin_amdgcn_rcpf((float)cnt) - ut);
        }
    }
    __syncthreads();
    bf16x8 pw[8][2]; f32x4 psc[8];
#pragma unroll
    for (int i = 0; i < 8; ++i) { const int id = F.wave + NWAVES * i, g = id >> 4, nt = id & 3;
        const bf16* wp = WP + ((size_t)(l * 4 + g) * 64 + 16 * nt + fr) * 64 + 8 * fq;
        pw[i][0] = *(const bf16x8*)(wp); pw[i][1] = *(const bf16x8*)(wp + 32); psc[i] = *(const f32x4*)(pool_s + l * 256 + 64 * g + 16 * nt + 4 * fq); }
#pragma unroll
    for (int i = 0; i < 8; ++i) { const int id = F.wave + NWAVES * i;
        const int g = id >> 4, mt = (id >> 2) & 3, nt = id & 3;
        f32x4 acc = (f32x4){0.f, 0.f, 0.f, 0.f};
#pragma unroll
        for (int kk = 0; kk < 2; ++kk) { const bf16x8 a = *(const LAS bf16x8*)(Ps + (16 * mt + fr) * 264 + 64 * g + 32 * kk + 8 * fq); acc = mma16(pw[i][kk], a, acc); }
        acc = acc * psc[i];
        v2u ow; ow.x = pk2(acc[0], acc[1]); ow.y = pk2(acc[2], acc[3]);
        *(v2u*)(MIXED + (row0 + 16 * mt + fr) * D + 768 + 64 * g + 16 * nt + 4 * fq) = ow;
    }
    __syncthreads();
}

__device__ __forceinline__ void m2_gla(Frame& F, int l, int unit) {
    FRAME_REFRESH(F);
    const bf16* const QK = P_QK; const float* const decay = P_decay; const float* const dst = P_dst; const float* const gla_ng = P_gla_ng;
    const int cgrp = unit & 7, hp = (unit >> 3) % 3, b = unit / 24; const bf16* const PROJ = P_PROJ_B(b); bf16* const MIXED = P_MIXED_B(b);
    const int half = F.wave >> 2, wq = F.wave & 3, h = 2 * hp + half, lh = wq * 64 + F.lane, fr = F.lane & 15, fq = F.lane >> 4;
    LAS bf16* base = (LAS bf16*)(F.lds + half * 52224);
    LAS bf16* Qs = base;
    LAS bf16* Ks = base + 2560;
    LAS bf16* Vs = base + 5120;
    LAS bf16* As = base + 9728;
    LAS bf16* St = base + 14336;
    LAS bf16* Gs = base + 16896;
    LAS bf16* Os = base + 21504;
    const int dk = lh >> 3, dv0 = (lh & 7) * 8;
    const size_t bh = (size_t)b * 6 + h;
    f32x4 S0 = (f32x4){0.f, 0.f, 0.f, 0.f}, S1 = S0;
    for (int j4 = 0; j4 < cgrp; ++j4) {
        float dc[4]; f32x4 e0[4], e1[4];
#pragma unroll
        for (int u = 0; u < 4; ++u) { const int j = 4 * j4 + u; dc[u] = decay[(bh * 32 + j) * 32 + dk]; const float* dp = dst + ((bh * 32 + j) * 32 + dk) * 64 + dv0; e0[u] = *(const f32x4*)dp; e1[u] = *(const f32x4*)(dp + 4); }
#pragma unroll
        for (int u = 0; u < 4; ++u) { S0 = S0 * dc[u] + e0[u]; S1 = S1 * dc[u] + e1[u]; }
    }
    float ngl[4];
#pragma unroll
    for (int nt = 0; nt < 4; ++nt) ngl[nt] = gla_ng[l * 384 + h * 64 + 16 * nt + fr];
    const int qr = lh >> 2, qc = lh & 3;
    v4u qv, kvv, vv[2], gv[2]; f32x4 d0, d1; float dcn;
#define GLA_FETCH(nn) do { const size_t rw_ = (size_t)b * SEQ + 64 * (nn); \
        qv = *(const v4u*)(QK + (rw_ + qr) * 384 + h * 32 + 8 * qc); kvv = *(const v4u*)(QK + (rw_ + qr) * 384 + 192 + h * 32 + 8 * qc); \
        _Pragma("unroll") for (int i_ = 0; i_ < 2; ++i_) { const int ix_ = lh + 256 * i_, r_ = ix_ >> 3, c_ = ix_ & 7; \
            vv[i_] = *(const v4u*)(PROJ + (rw_ + r_) * NPROJ + C_GV + h * 64 + 8 * c_); gv[i_] = *(const v4u*)(PROJ + (rw_ + r_) * NPROJ + C_OG + h * 64 + 8 * c_); } \
        dcn = decay[(bh * 32 + (nn)) * 32 + dk]; { const float* dp_ = dst + ((bh * 32 + (nn)) * 32 + dk) * 64 + dv0; d0 = *(const f32x4*)dp_; d1 = *(const f32x4*)(dp_ + 4); } } while (0)
    GLA_FETCH(4 * cgrp);
    for (int cc = 0; cc < 4; ++cc) {
        const int n = 4 * cgrp + cc; const size_t rowc = (size_t)b * SEQ + 64 * n;
#pragma unroll
        for (int e = 0; e < 4; ++e) { St[(dv0 + e) * 40 + dk] = (bf16)f2bf(S0[e]); St[(dv0 + 4 + e) * 40 + dk] = (bf16)f2bf(S1[e]); }
        *(LAS v4u*)(Qs + qr * 40 + 8 * qc) = qv; *(LAS v4u*)(Ks + qr * 40 + 8 * qc) = kvv;
#pragma unroll
        for (int i = 0; i < 2; ++i) { const int idx = lh + 256 * i, r = idx >> 3, ch = idx & 7;
            *(LAS v4u*)(Gs + r * 72 + 8 * ch) = gv[i];
            LAS bf16* vp = Vs + (8 * ch) * 72 + r; const v4u w = vv[i];
            vp[0 * 72] = (bf16)(w.x & 0xffffu); vp[1 * 72] = (bf16)(w.x >> 16); vp[2 * 72] = (bf16)(w.y & 0xffffu); vp[3 * 72] = (bf16)(w.y >> 16);
            vp[4 * 72] = (bf16)(w.z & 0xffffu); vp[5 * 72] = (bf16)(w.z >> 16); vp[6 * 72] = (bf16)(w.w & 0xffffu); vp[7 * 72] = (bf16)(w.w >> 16); }
        S0 = S0 * dcn + d0; S1 = S1 * dcn + d1;
        __syncthreads();
        if (cc < 3) GLA_FETCH(n + 1);
        const bf16x8 qa = *(const LAS bf16x8*)(Qs + (16 * wq + fr) * 40 + 8 * fq);
#pragma unroll
        for (int jt = 0; jt < 4; ++jt) {
            f32x4 a = (f32x4){0.f, 0.f, 0.f, 0.f};
            if (jt <= wq) { const bf16x8 kb = *(const LAS bf16x8*)(Ks + (16 * jt + fr) * 40 + 8 * fq); a = mma16(qa, kb, a); }
#pragma unroll
            for (int r = 0; r < 4; ++r) { const int i = 16 * wq + 4 * fq + r, j = 16 * jt + fr; As[i * 72 + j] = (bf16)f2bf((j <= i) ? a[r] : 0.f); }
        }
        LDS_WAIT(); asm volatile("" ::: "memory");
        f32x4 o[4];
        const bf16x8 a0 = *(const LAS bf16x8*)(As + (16 * wq + fr) * 72 + 8 * fq), a1 = *(const LAS bf16x8*)(As + (16 * wq + fr) * 72 + 32 + 8 * fq);
#pragma unroll
        for (int nt = 0; nt < 4; ++nt) {
            f32x4 acc = (f32x4){0.f, 0.f, 0.f, 0.f};
            acc = mma16(a0, *(const LAS bf16x8*)(Vs + (16 * nt + fr) * 72 + 8 * fq), acc);
            acc = mma16(a1, *(const LAS bf16x8*)(Vs + (16 * nt + fr) * 72 + 32 + 8 * fq), acc);
            acc = mma16(qa, *(const LAS bf16x8*)(St + (16 * nt + fr) * 40 + 8 * fq), acc);
            o[nt] = acc;
        }
#pragma unroll
        for (int r = 0; r < 4; ++r) {
            float ss = o[0][r] * o[0][r] + o[1][r] * o[1][r] + o[2][r] * o[2][r] + o[3][r] * o[3][r];
            ss += __builtin_bit_cast(float, __builtin_amdgcn_update_dpp(0, __builtin_bit_cast(int, ss), 0xB1, 0xF, 0xF, true));
            ss += __builtin_bit_cast(float, __builtin_amdgcn_update_dpp(0, __builtin_bit_cast(int, ss), 0x4E, 0xF, 0xF, true));
            ss += __builtin_bit_cast(float, __builtin_amdgcn_update_dpp(0, __builtin_bit_cast(int, ss), 0x141, 0xF, 0xF, true));
            ss += __builtin_bit_cast(float, __builtin_amdgcn_update_dpp(0, __builtin_bit_cast(int, ss), 0x140, 0xF, 0xF, true));
            const float rstd = __builtin_amdgcn_rsqf(ss * (1.0f / 64.0f) + RMS_EPS);
            const int i = 16 * wq + 4 * fq + r;
#pragma unroll
            for (int nt = 0; nt < 4; ++nt) { const int dv = 16 * nt + fr; const float og = bf2f(Gs[i * 72 + dv]);
                Os[i * 72 + dv] = (bf16)f2bf(o[nt][r] * rstd * ngl[nt] * (og * sigmoidf_(og))); }
        }
        LDS_WAIT(); asm volatile("" ::: "memory");
#pragma unroll
        for (int i2 = 0; i2 < 2; ++i2) { const int rr = 16 * wq + 8 * i2 + (F.lane >> 3), ch = F.lane & 7;
            *(v4u*)(MIXED + (rowc + rr) * D + 384 + h * 64 + 8 * ch) = *(const LAS v4u*)(Os + rr * 72 + 8 * ch); }
        __syncthreads();
    }
#undef GLA_FETCH
}

__device__ __forceinline__ int kperm(int rho) { return (rho & ~12) | ((rho & 4) << 1) | ((rho & 8) >> 1); }
__device__ __forceinline__ bf16x8 pack8(const f32x16& p, int s) {
    v4u w; w.x = pk2(p[8 * s + 0], p[8 * s + 1]); w.y = pk2(p[8 * s + 2], p[8 * s + 3]); w.z = pk2(p[8 * s + 4], p[8 * s + 5]); w.w = pk2(p[8 * s + 6], p[8 * s + 7]);
    return as_bf16x8(w);
}
constexpr float NEG_INF = -__builtin_inff();

template <int BR>
__device__ __forceinline__ void attn_tile(const LAS bf16* Kt, const LAS bf16* Vt, const bf16x8 (&qf)[4], f32x16 (&o)[2], float& mref, float& rmax, float& lsum, int d, int kind, int q, int hi, const f32x16& zero16) {
    f32x16 s[2];
    const int prow = kperm(q);
    {
        bf16x8 kf[2][4];
#pragma unroll
        for (int st = 0; st < 2; ++st)
#pragma unroll
            for (int ds = 0; ds < 4; ++ds) kf[st][ds] = *(const LAS bf16x8*)(Kt + (32 * st + prow) * 72 + 16 * ds + 8 * hi);
        __builtin_amdgcn_sched_barrier(0);
#pragma unroll
        for (int st = 0; st < 2; ++st) {
            s[st] = mma32(kf[st][0], qf[0], zero16);
#pragma unroll
            for (int ds = 1; ds < 4; ++ds) s[st] = mma32(kf[st][ds], qf[ds], s[st]);
        }
    }
    bf16x8 vf0[4];
#pragma unroll
    for (int k = 0; k < 4; ++k) vf0[k] = *(const LAS bf16x8*)(Vt + q * 72 + 16 * k + 8 * hi);
    __builtin_amdgcn_sched_barrier(0);
    if (__any(mref != 0.f)) {
#pragma unroll
        for (int st = 0; st < 2; ++st)
#pragma unroll
            for (int r = 0; r < 16; ++r) asm volatile("v_sub_f32 %0, %0, %1" : "+v"(s[st][r]) : "v"(mref));
    }
    if (kind == 1) {
        const float ninf = NEG_INF;
        if (BR == 0) {
#pragma unroll
            for (int st = 0; st < 2; ++st)
#pragma unroll
                for (int r = 0; r < 16; ++r) asm volatile("v_cmp_gt_i32 vcc, %1, %2\n\ts_nop 1\n\tv_cndmask_b32 %0, %0, %3, vcc" : "+v"(s[st][r]) : "n"(32 * st + 16 * (r >> 3) + (r & 7)), "v"(d), "v"(ninf) : "vcc");
        } else {
#pragma unroll
            for (int st = 0; st < 2; ++st)
#pragma unroll
                for (int r = 0; r < 16; ++r) { unsigned t_; asm volatile("v_subrev_u32 %1, %2, %3\n\tv_cmp_lt_u32 vcc, 511, %1\n\ts_nop 1\n\tv_cndmask_b32 %0, %0, %4, vcc" : "+v"(s[st][r]), "=&v"(t_) : "n"(32 * st + 16 * (r >> 3) + (r & 7)), "v"(d), "v"(ninf) : "vcc"); }
        }
    }
    const bool rowok = (BR == 1) || kind != 2 || d >= 0;
    float mx = NEG_INF;
#pragma unroll
    for (int st = 0; st < 2; ++st)
#pragma unroll
        for (int r = 0; r < 16; ++r) mx = fmaxf(mx, s[st][r]);
    if (BR == 0) mx = rowok ? mx : NEG_INF;
    mx = fmaxf(mx, shx(mx, 32, q + 32 * hi));
    rmax = fmaxf(rmax, mx);
    if (__any(rmax > 8.0f || (rmax < -100.0f && rmax != NEG_INF))) {
        const float delta = (rmax == NEG_INF) ? 0.f : rmax, alpha = ex2(-delta);
        mref += delta; rmax -= delta; lsum *= alpha;
#pragma unroll
        for (int st = 0; st < 2; ++st)
#pragma unroll
            for (int r = 0; r < 16; ++r) { asm volatile("v_mul_f32 %0, %0, %1" : "+v"(o[st][r]) : "v"(alpha)); asm volatile("v_sub_f32 %0, %0, %1" : "+v"(s[st][r]) : "v"(delta)); }
    }
    float ps = 0.f;
#pragma unroll
    for (int st = 0; st < 2; ++st)
#pragma unroll
        for (int r = 0; r < 16; ++r) { const float p = ex2(s[st][r]); s[st][r] = p; ps += p; }
    if (BR == 0) ps = rowok ? ps : 0.f;
    lsum += ps;
    bf16x8 pf[4];
#pragma unroll
    for (int k = 0; k < 4; ++k) { pf[k] = pack8(s[k >> 1], k & 1);
        if (BR == 0) { const unsigned m = rowok ? ~0u : 0u; v4u w = __builtin_bit_cast(v4u, pf[k]); w.x &= m; w.y &= m; w.z &= m; w.w &= m; pf[k] = as_bf16x8(w); } }
    bf16x8 vf1[4];
#pragma unroll
    for (int k = 0; k < 4; ++k) vf1[k] = *(const LAS bf16x8*)(Vt + (32 + q) * 72 + 16 * k + 8 * hi);
#pragma unroll
    for (int k = 0; k < 4; ++k) o[0] = mma32(vf0[k], pf[k], o[0]);
#pragma unroll
    for (int k = 0; k < 4; ++k) o[1] = mma32(vf1[k], pf[k], o[1]);
}
__device__ __forceinline__ void cmp_scores(const LAS bf16* KCs, const bf16x8 (&qf)[4], f32x16 (&s)[4], float& mx, int dc, int prow, int hi, int nst, int nfull) {
    mx = NEG_INF;
#pragma unroll
    for (int st = 0; st < 4; ++st) {
        if (st < nst) {
#pragma unroll
            for (int e = 0; e < 16; ++e) s[st][e] = 0.f;
            bf16x8 kf[4];
#pragma unroll
            for (int ds = 0; ds < 4; ++ds) kf[ds] = *(const LAS bf16x8*)(KCs + (32 * st + prow) * 72 + 16 * ds + 8 * hi);
#pragma unroll
            for (int ds = 0; ds < 4; ++ds) s[st] = mma32(kf[ds], qf[ds], s[st]);
            if (st < nfull) {
#pragma unroll
                for (int r = 0; r < 16; ++r) mx = fmaxf(mx, s[st][r]);
            } else {
#pragma unroll
                for (int r = 0; r < 16; ++r) { const int c16 = 16 * (32 * st + 16 * (r >> 3) + (r & 7)); const float v = (dc >= c16) ? s[st][r] : NEG_INF; s[st][r] = v; mx = fmaxf(mx, v); }
            }
        }
    }
    mx = fmaxf(mx, shx(mx, 32, (prow & ~12) | ((prow & 4) << 1) | ((prow & 8) >> 1) | (hi << 5)));
}
__device__ __forceinline__ void sort16(int (&a)[16]) {
#pragma unroll
    for (int k = 2; k <= 16; k <<= 1)
#pragma unroll
        for (int j = k >> 1; j > 0; j >>= 1)
#pragma unroll
            for (int i = 0; i < 16; ++i) { const int l = i ^ j;
                if (l > i) { const int x = a[i], y = a[l], lo = x < y ? x : y, hg = x < y ? y : x; const bool asc = (i & k) == 0; a[i] = asc ? lo : hg; a[l] = asc ? hg : lo; } }
}

__device__ __forceinline__ void m2_nsa(Frame& F, int uid) {
    FRAME_REFRESH(F);
    const bf16* const KC = P_KC; const bf16* const VCT = P_VC; const bf16* const VT = P_VT;
    const int h = uid % 3, bgp = uid / 3, pt = bgp >> 5, bg = bgp & 31, b = bg >> 1, g = bg & 1; const bf16* const PROJ = P_PROJ_B(b); bf16* const MIXED = P_MIXED_B(b);
    const int p0 = 256 * pt, pw = p0 + 32 * F.wave, q = F.lane & 31, hi = F.lane >> 5, pos = pw + q, cur = pw >> 6;
    const size_t rowq = (size_t)b * SEQ + pos;
    LAS bf16* KCs = (LAS bf16*)F.lds;
    LAS bf16* VCt = (LAS bf16*)(F.lds + 18432);
    LAS bf16* Ks0 = (LAS bf16*)(F.lds + 35840);
    LAS bf16* Vs0 = (LAS bf16*)(F.lds + 54272);
    LAS bf16* Kw0 = (LAS bf16*)(F.lds + 72704);
    LAS bf16* Vw0 = (LAS bf16*)(F.lds + 91136);
#pragma unroll
    for (int i = 0; i < 2; ++i) { const int idx = F.tid + 512 * i;
        { const int key = idx >> 3, ch = idx & 7; *(LAS v4u*)(KCs + key * 72 + 8 * ch) = *(const v4u*)(KC + ((size_t)bg * 128 + key) * 64 + 8 * ch); }
        { const int d = idx >> 4, ch = idx & 15; *(LAS v4u*)(VCt + d * 136 + 8 * ch) = *(const v4u*)(VCT + ((size_t)bg * 64 + d) * 128 + 8 * ch); } }
    __syncthreads();
    const int prow = kperm(q);
    const int pws = __builtin_amdgcn_readfirstlane(pw);
    const int nst = (pws >> 9) + 1, nfull = (pws >= 527) ? ((pws - 527) >> 9) + 1 : 0;
    unsigned selmask;
    {
        float loc[8][3];
#pragma unroll
        for (int G = 0; G < 8; ++G) { loc[G][0] = 0.f; loc[G][1] = 0.f; loc[G][2] = 0.f; }
#pragma unroll 1
        for (int hh = 0; hh < 3; ++hh) {
            bf16x8 qf[4];
#pragma unroll
            for (int ds = 0; ds < 4; ++ds) qf[ds] = *(const bf16x8*)(PROJ + rowq * NPROJ + C_Q + (g * 3 + hh) * 64 + 16 * ds + 8 * hi);
            f32x16 s[4]; float mx;
            { int dc = pos - 128 * hi - 31; asm volatile("" : "+v"(dc)); cmp_scores(KCs, qf, s, mx, dc, prow, hi, nst, nfull); }
            const float msafe = (mx == NEG_INF) ? 0.f : mx;
            float ps = 0.f;
#pragma unroll
            for (int st = 0; st < 4; ++st) if (st < nst) {
#pragma unroll
                for (int r = 0; r < 16; ++r) { const float p = ex2(s[st][r] - msafe); s[st][r] = p; ps += p; } }
            ps += shx(ps, 32, F.lane);
            const float inv = 1.0f / fmaxf(ps, 1e-30f);
#pragma unroll
            for (int st = 0; st < 4; ++st) if (st < nst)
#pragma unroll
                for (int u = 0; u < 2; ++u) { const int G = 2 * st + u; const int r0 = 8 * u;
                    loc[G][0] += (s[st][r0 + 0] + s[st][r0 + 1] + s[st][r0 + 2] + 0.5f * s[st][r0 + 3]) * inv;
                    loc[G][1] += (0.5f * s[st][r0 + 3] + s[st][r0 + 4] + s[st][r0 + 5] + s[st][r0 + 6] + 0.5f * s[st][r0 + 7]) * inv;
                    loc[G][2] += (0.5f * s[st][r0 + 7]) * inv; }
        }
        float imp[32];
#pragma unroll
        for (int G = 0; G < 8; ++G) {
            const float o0 = shx(loc[G][0], 32, F.lane), o1 = shx(loc[G][1], 32, F.lane), o2 = shx(loc[G][2], 32, F.lane);
            const float a0 = hi ? o0 : loc[G][0], a1 = hi ? o1 : loc[G][1], a2 = hi ? o2 : loc[G][2];
            const float b0 = hi ? loc[G][0] : o0, b1 = hi ? loc[G][1] : o1, b2 = hi ? loc[G][2] : o2;
            if (G == 0) imp[0] = a0; else imp[4 * G] += a0;
            imp[4 * G + 1] = a1; imp[4 * G + 2] = a2 + b0; imp[4 * G + 3] = b1;
            if (G < 7) imp[4 * G + 4] = b2;
        }
        const int curq = pos >> 6;
#pragma unroll
        for (int j = 0; j < 32; ++j) { float v = imp[j]; if (j == 0 || j == curq || j == curq - 1) v = 1.0e4f; if (j > curq) v = -1.0e4f; imp[j] = v; }
        int key[32];
#pragma unroll
        for (int j = 0; j < 32; ++j) { const unsigned u = __builtin_bit_cast(unsigned, imp[j]); const unsigned ord = (u & 0x80000000u) ? ~u : (u | 0x80000000u);
            key[j] = (int)(((ord >> 1) & ~31u) | (unsigned)(31 - j)); }
        int ka[16], kb[16];
#pragma unroll
        for (int j = 0; j < 16; ++j) { ka[j] = key[j]; kb[j] = key[16 + j]; }
        sort16(ka); sort16(kb);
        int thr = 0x7fffffff;
#pragma unroll
        for (int j = 0; j < 16; ++j) { const int mj = ka[j] > kb[15 - j] ? ka[j] : kb[15 - j]; thr = mj < thr ? mj : thr; }
        unsigned m16 = 0u;
#pragma unroll
        for (int jj = 0; jj < 16; ++jj) { const int kj = hi ? key[16 + jj] : key[jj]; m16 |= (((unsigned)(kj - thr) >> 31) ^ 1u) << jj; }
        selmask = hi ? (m16 << 16) : m16; selmask |= shxu(selmask, 32, F.lane);
    }
    const int kkey = F.tid >> 3, kch = F.tid & 7;
    const int t_hi = (p0 + 255) >> 6;
    const int w_lo = (p0 >= 511) ? ((p0 - 511) >> 6) : 0;
    bf16x8 qf[4];
#pragma unroll
    for (int ds = 0; ds < 4; ++ds) qf[ds] = *(const bf16x8*)(PROJ + rowq * NPROJ + C_Q + (g * 3 + h) * 64 + 16 * ds + 8 * hi);
    const bf16* gp = PROJ + rowq * NPROJ + C_GATE + (g * 3 + h) * 3;
    const float g0 = sigmoidf_(bf2f(gp[0])), g1 = sigmoidf_(bf2f(gp[1])), g2 = sigmoidf_(bf2f(gp[2]));
    f32x16 accO[2];
    f32x16 zero16;
#pragma unroll
    for (int e = 0; e < 16; ++e) zero16[e] = 0.f;
    asm volatile("" : "+v"(zero16));
    {
        const bf16* gKs = PROJ + ((size_t)b * SEQ + kkey) * NPROJ + C_KV + ((1 * 2 + 0) * 2 + g) * 64 + 8 * kch;
        const bf16* gKw = PROJ + ((size_t)b * SEQ + kkey) * NPROJ + C_KV + ((2 * 2 + 0) * 2 + g) * 64 + 8 * kch;
        const bf16* gVs = VT + ((size_t)((b * 2 + 0) * 2 + g) * 64 + kkey) * SEQ + 8 * kch;
        const bf16* gVw = VT + ((size_t)((b * 2 + 1) * 2 + g) * 64 + kkey) * SEQ + 8 * kch;
        const int lofs = kkey * 72 + 8 * kch;
        f32x16 os[2], ow[2]; float ms = 0.f, rs_ = NEG_INF, ls = 0.f, mw = 0.f, rw_ = NEG_INF, lw = 0.f;
#pragma unroll
        for (int dt = 0; dt < 2; ++dt)
#pragma unroll
            for (int e = 0; e < 16; ++e) { os[dt][e] = 0.f; ow[dt][e] = 0.f; }
        v4u ksr, vsr, kwr = (v4u){0u, 0u, 0u, 0u}, vwr = (v4u){0u, 0u, 0u, 0u};
        ksr = *(const v4u*)gKs; vsr = *(const v4u*)gVs;
        if (w_lo == 0) { kwr = *(const v4u*)gKw; vwr = *(const v4u*)gVw; }
        *(LAS v4u*)(Ks0 + lofs) = ksr; *(LAS v4u*)(Vs0 + lofs) = vsr; *(LAS v4u*)(Kw0 + lofs) = kwr; *(LAS v4u*)(Vw0 + lofs) = vwr;
        __syncthreads();
#pragma unroll 1
        for (int jt = 0; jt <= t_hi; ++jt) {
            const int nb = jt & 1;
            if (jt < t_hi) { ksr = *(const v4u*)(gKs + (size_t)(64 * (jt + 1)) * NPROJ); vsr = *(const v4u*)(gVs + 64 * (jt + 1));
                if (jt + 1 >= w_lo) { kwr = *(const v4u*)(gKw + (size_t)(64 * (jt + 1)) * NPROJ); vwr = *(const v4u*)(gVw + 64 * (jt + 1)); } }
            int dd = pos - 64 * jt - 8 * hi;
            {
                const bool sel = (selmask >> jt) & 1u;
                if (jt <= cur && __any(sel)) {
                    const int kind = (jt < cur) ? (__all(sel) ? 0 : 2) : 1;
                    int ds_ = (jt < cur) ? (sel ? 0 : -1) : (sel ? dd : -1); asm volatile("" : "+v"(ds_));
                    attn_tile<0>(Ks0 + nb * 4608, Vs0 + nb * 4608, qf, os, ms, rs_, ls, ds_, kind, q, hi, zero16);
                }
            }
            if (64 * jt + 63 + 511 >= pw && 64 * jt <= pw + 31) {
                const int kind = (64 * jt + 63 <= pw && 64 * jt + 511 >= pw + 31) ? 0 : 1;
                asm volatile("" : "+v"(dd));
                attn_tile<1>(Kw0 + nb * 4608, Vw0 + nb * 4608, qf, ow, mw, rw_, lw, dd, kind, q, hi, zero16);
            }
            if (jt < t_hi) { const int o2 = (nb ^ 1) * 4608 + lofs; *(LAS v4u*)(Ks0 + o2) = ksr; *(LAS v4u*)(Vs0 + o2) = vsr; if (jt + 1 >= w_lo) { *(LAS v4u*)(Kw0 + o2) = kwr; *(LAS v4u*)(Vw0 + o2) = vwr; } }
            __syncthreads();
        }
        ls += shx(ls, 32, F.lane); lw += shx(lw, 32, F.lane);
        const float s1 = g1 / fmaxf(ls, 1e-30f), s2 = g2 / fmaxf(lw, 1e-30f);
        accO[0] = os[0] * s1 + ow[0] * s2; accO[1] = os[1] * s1 + ow[1] * s2;
    }
    {
        f32x16 s[4]; float mx;
        { int dc = pos - 128 * hi - 31; asm volatile("" : "+v"(dc)); cmp_scores(KCs, qf, s, mx, dc, prow, hi, nst, nfull); }
        const float msafe = (mx == NEG_INF) ? 0.f : mx;
        float ps = 0.f;
#pragma unroll
        for (int st = 0; st < 4; ++st) if (st < nst) {
#pragma unroll
            for (int r = 0; r < 16; ++r) { const float p = ex2(s[st][r] - msafe); s[st][r] = p; ps += p; } }
        ps += shx(ps, 32, F.lane);
        const float sc = g0 / fmaxf(ps, 1e-30f);
#pragma unroll
        for (int dt = 0; dt < 2; ++dt) {
            f32x16 o;
#pragma unroll
            for (int e = 0; e < 16; ++e) o[e] = 0.f;
            bf16x8 vf[8];
#pragma unroll
            for (int k = 0; k < 8; ++k) vf[k] = *(const LAS bf16x8*)(VCt + (32 * dt + q) * 136 + 16 * k + 8 * hi);
#pragma unroll
            for (int k = 0; k < 8; ++k) if ((k >> 1) < nst) o = mma32(vf[k], pack8(s[k >> 1], k & 1), o);
            accO[dt] = accO[dt] + o * sc;
        }
    }
    bf16* op = MIXED + rowq * D + (g * 3 + h) * 64 + 4 * hi;
#pragma unroll
    for (int dt = 0; dt < 2; ++dt)
#pragma unroll
        for (int rg = 0; rg < 4; ++rg) { v2u w; w.x = pk2(accO[dt][4 * rg + 0], accO[dt][4 * rg + 1]); w.y = pk2(accO[dt][4 * rg + 2], accO[dt][4 * rg + 3]); *(v2u*)(op + 32 * dt + 8 * rg) = w; }
    __syncthreads();
}
__device__ const unsigned short M2_OFFS[257] = {0,4,8,12,16,20,24,28,32,36,40,44,48,52,56,60,64,68,72,76,80,84,88,92,96,100,104,108,112,116,120,124,128,132,136,140,144,148,152,156,160,164,168,172,176,180,184,188,192,196,200,204,208,212,216,220,224,228,232,236,240,244,248,252,256,260,264,268,272,276,280,284,288,292,296,300,304,308,312,316,320,324,328,332,336,340,344,348,352,356,360,364,368,372,376,380,384,389,394,399,404,409,414,419,424,429,434,439,444,449,454,459,464,469,474,479,484,489,494,499,504,509,514,519,524,529,534,539,544,549,554,559,564,569,574,579,584,589,594,599,604,609,614,619,624,629,634,639,644,649,654,659,664,669,674,679,684,689,694,699,704,708,712,716,720,724,728,732,736,740,744,748,752,756,760,764,768,772,776,780,784,788,792,796,800,804,808,812,816,820,824,828,832,837,842,847,852,857,862,867,872,877,882,887,892,897,902,907,912,917,922,927,932,937,942,947,952,957,962,967,972,977,982,987,992,997,1002,1007,1012,1017,1022,1027,1032,1037,1042,1047,1052,1057,1062,1067,1072,1077,1082,1087,1092,1097,1102,1107,1112,1117,1122,1127,1132,1137,1142,1147,1152};
__device__ const unsigned short M2_LIST[1152] = {672,496,774,1027,673,497,782,1035,674,498,790,1043,675,499,798,1051,676,500,806,1059,677,501,814,1067,678,502,822,1075,679,503,830,1083,680,504,838,1091,681,505,846,1099,682,506,854,1107,683,507,862,1115,684,508,870,1123,685,509,878,1131,686,510,886,1139,687,511,894,1147,688,512,775,770,689,513,783,778,690,514,791,786,691,515,799,794,692,516,807,802,693,517,815,810,694,518,823,818,695,519,831,826,696,520,839,834,697,521,847,842,698,522,855,850,699,523,863,858,700,524,871,866,701,525,879,874,702,526,887,882,703,527,895,890,704,528,160,896,705,529,161,904,706,530,162,912,707,531,163,920,708,532,164,928,709,533,165,936,710,534,166,944,711,535,167,952,712,536,168,960,713,537,169,968,714,538,170,976,715,539,171,984,716,540,172,992,717,541,173,1000,718,542,174,1008,719,543,175,1016,720,480,176,1024,721,481,177,1032,722,482,178,1040,723,483,179,1048,724,484,180,1056,725,485,181,1064,726,486,182,1072,727,487,183,1080,728,488,184,1088,729,489,185,1096,730,490,186,1104,731,491,187,1112,732,492,188,1120,733,493,189,1128,734,494,190,1136,735,495,191,1144,736,192,224,128,737,193,225,129,738,194,226,130,739,195,227,131,740,196,228,132,741,197,229,133,742,198,230,134,743,199,231,135,744,200,232,136,745,201,233,137,746,202,234,138,747,203,235,139,748,204,236,140,749,205,237,141,750,206,238,142,751,207,239,143,752,208,240,144,753,209,241,145,754,210,242,146,755,211,243,147,756,212,244,148,757,213,245,149,758,214,246,150,759,215,247,151,760,216,248,152,761,217,249,153,762,218,250,154,763,219,251,155,764,220,252,156,765,221,253,157,766,222,254,158,767,223,255,159,576,368,1028,897,64,577,369,1036,905,65,578,370,1044,913,66,579,371,1052,921,67,580,372,1060,929,68,581,373,1068,937,69,582,374,1076,945,70,583,375,1084,953,71,584,376,1092,961,72,585,377,1100,969,73,586,378,1108,977,74,587,379,1116,985,75,588,380,1124,993,76,589,381,1132,1001,77,590,382,1140,1009,78,591,383,1148,1017,79,592,304,903,771,0,593,305,911,779,1,594,306,919,787,2,595,307,927,795,3,596,308,935,803,4,597,309,943,811,5,598,310,951,819,6,599,311,959,827,7,600,312,967,835,8,601,313,975,843,9,602,314,983,851,10,603,315,991,859,11,604,316,999,867,12,605,317,1007,875,13,606,318,1015,883,14,607,319,1023,891,15,608,288,1031,899,16,609,289,1039,907,17,610,290,1047,915,18,611,291,1055,923,19,612,292,1063,931,20,613,293,1071,939,21,614,294,1079,947,22,615,295,1087,955,23,616,296,1095,963,24,617,297,1103,971,25,618,298,1111,979,26,619,299,1119,987,27,620,300,1127,995,28,621,301,1135,1003,29,622,302,1143,1011,30,623,303,1151,1019,31,624,320,1029,769,80,625,321,1037,777,81,626,322,1045,785,82,627,323,1053,793,83,628,324,1061,801,84,629,325,1069,809,85,630,326,1077,817,86,631,327,1085,825,87,632,328,1093,833,88,633,329,1101,841,89,634,330,1109,849,90,635,331,1117,857,91,636,332,1125,865,92,637,333,1133,873,93,638,334,1141,881,94,639,335,1149,889,95,640,448,256,1025,641,449,257,1033,642,450,258,1041,643,451,259,1049,644,452,260,1057,645,453,261,1065,646,454,262,1073,647,455,263,1081,648,456,264,1089,649,457,265,1097,650,458,266,1105,651,459,267,1113,652,460,268,1121,653,461,269,1129,654,462,270,1137,655,463,271,1145,656,432,272,768,657,433,273,776,658,434,274,784,659,435,275,792,660,436,276,800,661,437,277,808,662,438,278,816,663,439,279,824,664,440,280,832,665,441,281,840,666,442,282,848,667,443,283,856,668,444,284,864,669,445,285,872,670,446,286,880,671,447,287,888,544,416,902,772,32,545,417,910,780,33,546,418,918,788,34,547,419,926,796,35,548,420,934,804,36,549,421,942,812,37,550,422,950,820,38,551,423,958,828,39,552,424,966,836,40,553,425,974,844,41,554,426,982,852,42,555,427,990,860,43,556,428,998,868,44,557,429,1006,876,45,558,430,1014,884,46,559,431,1022,892,47,560,464,1030,900,48,561,465,1038,908,49,562,466,1046,916,50,563,467,1054,924,51,564,468,1062,932,52,565,469,1070,940,53,566,470,1078,948,54,567,471,1086,956,55,568,472,1094,964,56,569,473,1102,972,57,570,474,1110,980,58,571,475,1118,988,59,572,476,1126,996,60,573,477,1134,1004,61,574,478,1142,1012,62,575,479,1150,1020,63,384,336,96,773,898,385,337,97,781,906,386,338,98,789,914,387,339,99,797,922,388,340,100,805,930,389,341,101,813,938,390,342,102,821,946,391,343,103,829,954,392,344,104,837,962,393,345,105,845,970,394,346,106,853,978,395,347,107,861,986,396,348,108,869,994,397,349,109,877,1002,398,350,110,885,1010,399,351,111,893,1018,400,352,112,901,1026,401,353,113,909,1034,402,354,114,917,1042,403,355,115,925,1050,404,356,116,933,1058,405,357,117,941,1066,406,358,118,949,1074,407,359,119,957,1082,408,360,120,965,1090,409,361,121,973,1098,410,362,122,981,1106,411,363,123,989,1114,412,364,124,997,1122,413,365,125,1005,1130,414,366,126,1013,1138,415,367,127,1021,1146};
__device__ const unsigned short M2L_OFFS[33] = {0,5,10,14,18,23,28,33,38,42,46,50,54,59,64,69,74,79,84,88,92,96,100,104,108,112,116,120,124,129,134,139,144};
__device__ const unsigned short M2L_LIST[144] = {84,24,14,96,4,85,25,15,104,5,86,64,12,99,87,65,13,107,76,44,133,113,6,77,45,141,121,7,82,46,115,131,8,83,47,123,139,9,92,40,28,98,93,41,29,106,94,26,30,135,95,27,31,143,52,58,103,119,10,53,59,111,127,11,74,36,101,97,0,75,37,109,105,1,60,56,117,129,2,61,57,125,137,3,72,78,102,132,73,79,110,140,80,54,32,114,81,55,33,122,62,66,34,130,63,67,35,138,88,68,118,100,89,69,126,108,90,70,134,116,91,71,142,124,48,42,18,20,112,49,43,19,21,120,50,38,16,22,128,51,39,17,23,136};


#ifndef MK_PER_PHASE
#define MK_PER_PHASE 0
#endif
constexpr int PH_PER_LAYER = 6;
constexpr int N_PHASES = 2 + PH_PER_LAYER * DEPTH;
__global__ void __launch_bounds__(NWAVES * 64, 2) hymba_fwd(Args args) {
    extern __shared__ __attribute__((aligned(16))) unsigned char lds[];
    Frame F;
    F.lds = (LAS unsigned char*)lds;
    F.G = gridDim.x; F.wave0 = __builtin_amdgcn_readfirstlane((int)threadIdx.x >> 6); F.cid = blockIdx.x; F.lok = 0; FRAME_REFRESH(F);
    for (int u = F.tid; u < (LDS_BYTES - LDSCTL_OFF) / 4; u += NWAVES * 64) ((LAS unsigned*)(F.lds + LDSCTL_OFF))[u] = 0u;
    __syncthreads();
    unsigned* barw = (unsigned*)(args.ws + WS_CTL) + CW_BAR;
    XcdBarrier bar; bar.bar = barw; bar.x = 0; bar.st = nullptr;
    if (!MK_PER_PHASE) bar = xcd_barrier_post(barw, (volatile LAS unsigned*)(F.lds + LDSCTL_OFF + 64));
    const int lo = args.ph_lo, hi = args.ph_hi;
#define IN(k) (lo <= (k) && (k) < hi)
#define SEAM(k) do { if (!MK_PER_PHASE && IN(k) && IN((k) + 1)) { unsigned* bb_ = (unsigned*)(P_WS + WS_CTL) + CW_BAR; bar.bar = bb_; FRAME_REFRESH(F); xcd_barrier(bar, F.tid == 0); } } while (0)

#define SEAML(k) do { if (!MK_PER_PHASE && IN(k) && IN((k) + 1)) { unsigned* bb_ = (unsigned*)(P_WS + WS_CTL) + CW_BAR; bar.bar = bb_; FRAME_REFRESH(F); if (F.lok) xcd_barrier_local(bar, F.tid == 0); else xcd_barrier(bar, F.tid == 0); } } while (0)
    if (IN(0)) { FRAME_REFRESH(F); p0_prologue(F); }
    SEAM(0);
    if (!MK_PER_PHASE && IN(0) && IN(1)) {
        volatile LAS int* lw = (volatile LAS int*)(F.lds + LDSCTL_OFF + 64);
        FRAME_REFRESH(F);
        if (F.tid == 0) lw[4] = xcd_local_id(bar, (unsigned)F.G);
        __syncthreads();
        const int id_ = __builtin_amdgcn_readfirstlane(lw[4]);
        if (id_ >= 0) { F.cid = id_; F.lok = 1; }
    }
#pragma unroll 1
    for (int l = 0; l < DEPTH; ++l) {
        const int pb = 1 + PH_PER_LAYER * l;
        if (IN(pb + 0)) {
            FRAME_REFRESH(F);
            pg8::Gemm g{P_XN, P_WIN + (size_t)l * NPROJ * D, T, NPROJ, D}; pg8::StaticOrder S; S.init(T, NPROJ, F.G, (int)F.bid);
            pg8::EpiProj E{P_PROJ, P_rope, NPROJ, QSCALE, l == 0 ? (const float*)nullptr : (const float*)P_ST(2 * l - 1), P_CV + CV_C1IN + l * NPROJ, P_CV + CV_C2IN + l * NPROJ, SLAB_PADP / 2};
            pg8::gemm_phase<pg8::EpiProj, pg8::StaticOrder, true, true>(F.lds, g, S, E, F.wave);
        }
        SEAML(pb + 0);
        if (IN(pb + 1)) {
            FRAME_REFRESH(F);
            if (l == 0) fold_vectors_reduce(F);
#define XUNITS(u, N) for (int k_ = 0, u = F.lok ? (F.bid & 7) * ((N) / 8) + (F.bid >> 3) : F.bid; F.lok ? k_ < (N) / 256 : u < (N); ++k_, u += F.lok ? 32 : F.G)
            XUNITS(u, 256) m1_compress(F, l, u);
            XUNITS(u, 512) m1_vt(F, u);
            XUNITS(u, 512) m1_gla_pool(F, l, u);
        }
        if (l == 0) SEAM(pb + 1); else SEAML(pb + 1);
        if (IN(pb + 2)) {
            FRAME_REFRESH(F);
            if (F.lok) {
                const int x = F.bid & 7, r = F.bid >> 3;
#pragma unroll 1
                for (int i = __builtin_amdgcn_readfirstlane((int)M2L_OFFS[r]), i1 = __builtin_amdgcn_readfirstlane((int)M2L_OFFS[r + 1]); i < i1; ++i) { const int lid = __builtin_amdgcn_readfirstlane((int)M2L_LIST[i]);
                    if (lid < 96) { const int hh = lid % 3, t_ = lid / 3; m2_nsa(F, ((t_ >> 2) * 32 + 4 * x + (t_ & 3)) * 3 + hh); } else m2_gla(F, l, (lid - 96) + 48 * x); }
            } else {
#pragma unroll 1
            for (int w = F.bid; w < 256; w += F.G) {
#pragma unroll 1
                for (int i = __builtin_amdgcn_readfirstlane((int)M2_OFFS[w]), i1 = __builtin_amdgcn_readfirstlane((int)M2_OFFS[w + 1]); i < i1; ++i) { const int id = __builtin_amdgcn_readfirstlane((int)M2_LIST[i]);
                    if (id < 768) m2_nsa(F, id); else m2_gla(F, l, id - 768); } }
            }
        }
        SEAML(pb + 2);
        if (IN(pb + 3)) {
            FRAME_REFRESH(F);
            pg8::Gemm g{P_MIXED, P_WOUT + (size_t)l * D * D, T, D, D, SLAB_PADM}; pg8::StaticOrder S; S.init(T, D, F.G, (int)F.bid);
            const int kin = l == 0 ? 0 : 2 * l - 1;
            pg8::EpiRes E{l == 0 ? P_x : (const float*)nullptr, P_XN, P_ST(0), P_GB + kin * 2048, D, kin, 2 * l, ALPHA};
            pg8::gemm_phase<pg8::EpiRes, pg8::StaticOrder, true, true>(F.lds, g, S, E, F.wave);
        }
        SEAML(pb + 3);
        if (IN(pb + 4)) {
            FRAME_REFRESH(F);
            pg8::Gemm g{P_XN, P_WUP + (size_t)l * D * FF, T, FF, D}; pg8::StaticOrder S; S.init(T, FF, F.G, (int)F.bid);
            pg8::EpiRelu2 E{P_U, FF, P_ST(2 * l), P_CV + CV_C1UP + l * FF, P_CV + CV_C2UP + l * FF};
            pg8::gemm_phase<pg8::EpiRelu2, pg8::StaticOrder, true, true>(F.lds, g, S, E, F.wave);
        }
        SEAML(pb + 4);
        if (IN(pb + 5)) {
            FRAME_REFRESH(F);
            pg8::Gemm g{P_U, P_WDN + (size_t)l * D * FF, T, D, FF}; pg8::StaticOrder S; S.init(T, D, F.G, (int)F.bid);
            pg8::EpiRes E{(const float*)nullptr, P_XN, P_ST(0), P_GB + (2 * l) * 2048, D, 2 * l, 2 * l + 1, ALPHA};
            pg8::gemm_phase<pg8::EpiRes, pg8::StaticOrder, true, true>(F.lds, g, S, E, F.wave);
        }
        if (l + 1 < DEPTH) SEAML(pb + 5); else SEAM(pb + 5);
    }
    if (IN(1 + PH_PER_LAYER * DEPTH)) { FRAME_REFRESH(F); final_ln_phase(F, P_ST(2 * DEPTH - 1), P_ln2_g + (DEPTH - 1) * D, P_ln2_b + (DEPTH - 1) * D); }
#undef IN
#undef SEAM
}

extern "C" void kernel_launch(void* const* d_in, const int* in_sizes, int n_in, void* d_out, int out_size, void* d_ws, size_t ws_size, hipStream_t stream) {
    static int grid = 0;
    if (grid == 0) {
        if (n_in != 17 || in_sizes[0] != T * D || out_size != T * D || ws_size < WS_END) { fprintf(stderr, "kernel_launch: unexpected problem (n_in %d, in0 %d, out %d, ws %zu); nothing launched\n", n_in, n_in > 0 ? in_sizes[0] : -1, out_size, ws_size); grid = -1; return; }
        int dev = 0, cus = 0, per_cu = 0;
        if (hipGetDevice(&dev) != hipSuccess || hipDeviceGetAttribute(&cus, hipDeviceAttributeMultiprocessorCount, dev) != hipSuccess) { grid = -1; return; }
        if (hipFuncSetAttribute((const void*)hymba_fwd, hipFuncAttributeMaxDynamicSharedMemorySize, LDS_BYTES) != hipSuccess) { fprintf(stderr, "kernel_launch: hipFuncSetAttribute failed\n"); grid = -1; return; }
        if (hipOccupancyMaxActiveBlocksPerMultiprocessor(&per_cu, (const void*)hymba_fwd, NWAVES * 64, LDS_BYTES) != hipSuccess || per_cu < 1) { fprintf(stderr, "kernel_launch: occupancy query says %d blocks per CU\n", per_cu); per_cu = 1; }
        (void)hipGetLastError();
        grid = cus;
    }
    if (grid < 0) return;
    if (hipMemsetAsync((char*)d_ws + WS_CTL, 0, CTL_ZERO_BYTES, stream) != hipSuccess) { fprintf(stderr, "kernel_launch: memset failed\n"); return; }
    Args a{};
    for (int i = 0; i < 17; ++i) a.in[i] = (const float*)d_in[i];
    a.out = (float*)d_out; a.ws = (unsigned char*)d_ws;
#if MK_PER_PHASE
    for (int p = 0; p < N_PHASES; ++p) { a.ph_lo = p; a.ph_hi = p + 1; hipLaunchKernelGGL(hymba_fwd, dim3(grid), dim3(NWAVES * 64), LDS_BYTES, stream, a); }
#else
    a.ph_lo = 0; a.ph_hi = N_PHASES;
    hipLaunchKernelGGL(hymba_fwd, dim3(grid), dim3(NWAVES * 64), LDS_BYTES, stream, a);
#endif
    const hipError_t le = hipPeekAtLastError();
    if (le != hipSuccess) fprintf(stderr, "kernel_launch: launch failed: %s\n", hipGetErrorName(le));
}
```

```cpp
#include <hip/hip_runtime.h>
#include <cstdio>
#include <cstdint>
__device__ __forceinline__ float shx(float v, int mask, int lane) { return __builtin_bit_cast(float, __builtin_amdgcn_ds_bpermute((lane ^ mask) << 2, __builtin_bit_cast(int, v))); }
__device__ __forceinline__ unsigned shxu(unsigned v, int mask, int lane) { return (unsigned)__builtin_amdgcn_ds_bpermute((lane ^ mask) << 2, (int)v); }
namespace pg8 {
#define PG8_LAS __attribute__((address_space(3)))
typedef unsigned short bf16_t;
typedef short bf16x8 __attribute__((ext_vector_type(8)));
typedef float f32x4 __attribute__((ext_vector_type(4)));
typedef unsigned u32x4 __attribute__((ext_vector_type(4)));
constexpr int BM = 256, BK = 64, HALF = 128, HTB = HALF * BK * 2  , STAGE_BYTES = 8 * HTB, NXCD = 8, WGM = 8;

__host__ __device__ __forceinline__ int lds_byte(int r, int c) { const int st = (r >> 4) * 2 + (c >> 5), rr = r & 15, cc = c & 31, ob = rr * 64 + cc * 2; return st * 1024 + (ob ^ (((ob >> 9) & 1) << 5)); }
__host__ __device__ __forceinline__ void stage_rc(int b, int& R, int& C) { const int st = b / 1024, sb = b % 1024, swz = sb ^ (((sb >> 9) & 1) << 5); R = (st >> 1) * 16 + swz / 64; C = (st & 1) * 32 + (swz % 64) / 2; }
__host__ __device__ __forceinline__ int perm32(int rho) { const int n = rho >> 4, i = rho & 15; return 8 * (i >> 2) + 4 * n + (i & 3); }

struct Unit { int pm, pn; };
struct Gemm { const bf16_t* A; const bf16_t* Bt; int M, N, K; size_t apad = 0; };

struct StaticOrder {
    int nM, nN, nwg, G, c;
    __host__ __device__ void init(int M, int N, int G_, int c_) { nM = M / BM; nN = N / BM; nwg = nM * nN; G = G_; c = c_; }
    __host__ __device__ bool next(int i, Unit& u) const {
        const long L = (long)i * G + c; if (L >= nwg) return false;
        int wgid = (int)L; { const int q = nwg / NXCD, r = nwg % NXCD, xcd = wgid % NXCD, off = wgid / NXCD; wgid = (xcd < r ? xcd * (q + 1) : r * (q + 1) + (xcd - r) * q) + off; }
        const int nig = WGM * nN, gid = wgid / nig, fm = gid * WGM, gsz = (nM - fm) < WGM ? (nM - fm) : WGM;
        u.pm = fm + ((wgid % nig) % gsz); u.pn = (wgid % nig) / gsz; return true;
    }
    __device__ __forceinline__ void a_ready(const Unit&) const {}
    __device__ __forceinline__ void done(const Unit&) const {}
};

__device__ __forceinline__ unsigned cvt_pk_bf16(float lo, float hi) { unsigned r; asm volatile("v_cvt_pk_bf16_f32 %0, %1, %2" : "=v"(r) : "v"(lo), "v"(hi)); return r; }
typedef float f32x2 __attribute__((ext_vector_type(2)));
constexpr float LNF_EPS = 1e-5f;
__device__ __forceinline__ void row_stats_finish(f32x2 v, float& mu, float& rstd, int lane) {
    float s = v[0], ss = v[1];
    s += shx(s, 16, lane); ss += shx(ss, 16, lane); s += shx(s, 32, lane); ss += shx(ss, 32, lane);
    mu = s * (1.0f / 1024.0f); const float var = fmaxf(ss * (1.0f / 1024.0f) - mu * mu, 0.f); rstd = __builtin_amdgcn_rsqf(var + LNF_EPS);
}
__device__ __forceinline__ void row_stats8_load(const float* st, int row0, int fq, f32x2 (&raw)[8]) {
#pragma unroll
    for (int i = 0; i < 8; ++i) raw[i] = *(const f32x2*)(st + (size_t)(row0 + (i >> 2) * HALF + (i & 3) * 16) * 8 + 2 * fq);
}
struct EpiProj {
    static constexpr bool PERM = true, AFTER_DRAIN = false, CONTIG = true;
    bf16_t* O; const float* rope; int ldc; float qscale; const float* st; const float* c1; const float* c2; size_t opad; int ncol;
    __device__ __forceinline__ void operator()(const f32x4 (&acc)[2][2][4][2], const Unit& u, int wr, int wc, int fr, int fq, PG8_LAS unsigned char*, int) const {
        const int row0 = u.pm * BM + wr * 64 + fr;
        const int cg0 = u.pn * BM + wc * 64, h64 = cg0 >> 6;
        if (cg0 >= ncol) return;
        const bool roped = (h64 < 6 || (h64 < 18 && (((h64 - 6) >> 1) & 1) == 0));
        const float sc = (cg0 < 384) ? qscale : 1.0f;
        f32x4 k1[2][2], k2[2][2];
#pragma unroll
        for (int bj = 0; bj < 2; ++bj)
#pragma unroll
            for (int n = 0; n < 2; ++n) { k1[bj][n] = (f32x4){0.f, 0.f, 0.f, 0.f}; k2[bj][n] = k1[bj][n];
                if (st) { k1[bj][n] = *(const f32x4*)(c1 + cg0 + bj * 32 + 8 * fq + 4 * n); k2[bj][n] = *(const f32x4*)(c2 + cg0 + bj * 32 + 8 * fq + 4 * n); } }
        f32x2 raw[8];
#pragma unroll
        for (int i = 0; i < 8; ++i) raw[i] = (f32x2){0.f, 0.f};
        if (st) row_stats8_load(st, row0, fq, raw);
        const bool odd = fr & 1;
        bf16_t* const obase = O + (size_t)(u.pm >> 4) * opad + (size_t)(row0 - (fr & 1)) * ldc + cg0 + (fr & 1) * 32 + 8 * fq;
#pragma unroll
        for (int ai = 0; ai < 2; ++ai)
#pragma unroll
            for (int m = 0; m < 4; ++m) {
                const int row = row0 + ai * HALF + m * 16;
                float mu = 0.f, rs = 1.f; if (st) row_stats_finish(raw[ai * 4 + m], mu, rs, fr + 16 * fq);
                u32x4 w[2];
#pragma unroll
                for (int bj = 0; bj < 2; ++bj) {
                    f32x4 v0 = (acc[ai][bj][m][0] - k1[bj][0] * mu) * rs + k2[bj][0], v1 = (acc[ai][bj][m][1] - k1[bj][1] * mu) * rs + k2[bj][1];
                    if (bj == 0 && roped) {
                        f32x4 o0, o1;
#pragma unroll
                        for (int e = 0; e < 4; ++e) { o0[e] = shx(v0[e], 16, fr + 16 * fq); o1[e] = shx(v1[e], 16, fr + 16 * fq); }
                        if (fq < 2) {
                            const float* rp = rope + (size_t)(row & 2047) * 16;
                            const f32x4 c0 = *(const f32x4*)(rp), cc1 = *(const f32x4*)(rp + 4), s0 = *(const f32x4*)(rp + 8), s1 = *(const f32x4*)(rp + 12);
                            const float sg = (fq == 0) ? -1.0f : 1.0f;
                            v0 = v0 * c0 + o0 * (s0 * sg); v1 = v1 * cc1 + o1 * (s1 * sg);
                        }
                    }
                    v0 = v0 * sc; v1 = v1 * sc;
                    w[bj].x = cvt_pk_bf16(v0[0], v0[1]); w[bj].y = cvt_pk_bf16(v0[2], v0[3]); w[bj].z = cvt_pk_bf16(v1[0], v1[1]); w[bj].w = cvt_pk_bf16(v1[2], v1[3]);
                }
                u32x4 wa, wb;
#pragma unroll
                for (int e = 0; e < 4; ++e) { const unsigned snd = odd ? w[0][e] : w[1][e];
                    const unsigned rcv = (unsigned)__builtin_amdgcn_update_dpp(0, (int)snd, 0xB1, 0xF, 0xF, true);
                    wa[e] = odd ? rcv : w[0][e]; wb[e] = odd ? w[1][e] : rcv; }
                bf16_t* rowp = obase + (size_t)(ai * HALF + m * 16) * ldc;
                *(u32x4*)rowp = wa; *(u32x4*)(rowp + ldc) = wb;
            }
    }
};
struct EpiRelu2 {
    static constexpr bool PERM = true, AFTER_DRAIN = false, CONTIG = true;
    bf16_t* O; int ldc; const float* st; const float* c1; const float* c2;
    __device__ __forceinline__ void operator()(const f32x4 (&acc)[2][2][4][2], const Unit& u, int wr, int wc, int fr, int fq, PG8_LAS unsigned char* l, int t) const { run<true>(acc, u, wr, wc, fr, fq, l, t); }
    template <bool STORE>
    __device__ __forceinline__ void run(const f32x4 (&acc)[2][2][4][2], const Unit& u, int wr, int wc, int fr, int fq, PG8_LAS unsigned char*, int) const {
        const int row0 = u.pm * BM + wr * 64 + fr; const int col0 = u.pn * BM + wc * 64 + 8 * fq;
        f32x4 k1[2][2], k2[2][2];
#pragma unroll
        for (int bj = 0; bj < 2; ++bj)
#pragma unroll
            for (int n = 0; n < 2; ++n) { k1[bj][n] = *(const f32x4*)(c1 + col0 + bj * 32 + 4 * n); k2[bj][n] = *(const f32x4*)(c2 + col0 + bj * 32 + 4 * n); }
        f32x2 raw[8]; row_stats8_load(st, row0, fq, raw);
        const bool odd = fr & 1;
        bf16_t* const obase = O + (size_t)(row0 - (fr & 1)) * ldc + col0 + (fr & 1) * 32;
#pragma unroll
        for (int ai = 0; ai < 2; ++ai)
#pragma unroll
            for (int m = 0; m < 4; ++m) { float mu, rs; row_stats_finish(raw[ai * 4 + m], mu, rs, fr + 16 * fq);
                u32x4 w[2];
#pragma unroll
                for (int bj = 0; bj < 2; ++bj) { f32x4 v0 = (acc[ai][bj][m][0] - k1[bj][0] * mu) * rs + k2[bj][0], v1 = (acc[ai][bj][m][1] - k1[bj][1] * mu) * rs + k2[bj][1];
#pragma unroll
                    for (int e = 0; e < 4; ++e) { const float a = fmaxf(v0[e], 0.f), b = fmaxf(v1[e], 0.f); v0[e] = a * a; v1[e] = b * b; }
                    w[bj].x = cvt_pk_bf16(v0[0], v0[1]); w[bj].y = cvt_pk_bf16(v0[2], v0[3]); w[bj].z = cvt_pk_bf16(v1[0], v1[1]); w[bj].w = cvt_pk_bf16(v1[2], v1[3]); }
                u32x4 wa, wb;
#pragma unroll
                for (int e = 0; e < 4; ++e) { const unsigned snd = odd ? w[0][e] : w[1][e];
                    const unsigned rcv = (unsigned)__builtin_amdgcn_update_dpp(0, (int)snd, 0xB1, 0xF, 0xF, true);
                    wa[e] = odd ? rcv : w[0][e]; wb[e] = odd ? w[1][e] : rcv; }
                bf16_t* rowp = obase + (size_t)(ai * HALF + m * 16) * ldc;
                if (STORE) { *(u32x4*)rowp = wa; *(u32x4*)(rowp + ldc) = wb; } else { asm volatile("" :: "v"(wa)); asm volatile("" :: "v"(wb)); } }
    }
};
struct EpiRes {
    static constexpr bool PERM = true, AFTER_DRAIN = false, CONTIG = true;
    const float* resf; bf16_t* xb; float* stb; const float* gb; int ldc, k_in, k_out; float alpha;
    __device__ __forceinline__ void operator()(f32x4 (&acc)[2][2][4][2], const Unit& u, int wr, int wc, int fr, int fq, PG8_LAS unsigned char* lds, int tid) const {
        const int col0 = u.pn * BM + wc * 64 + 8 * fq;
        const float* st_in = stb + (size_t)(k_in & 1) * (32768 * 8); float* st_out = stb + (size_t)(k_out & 1) * (32768 * 8);
        PG8_LAS f32x2* P = (PG8_LAS f32x2*)(lds + STAGE_BYTES);
        f32x4 gv[2][2], bv[2][2];
#pragma unroll
        for (int bj = 0; bj < 2; ++bj)
#pragma unroll
            for (int n = 0; n < 2; ++n) { gv[bj][n] = (f32x4){1.f, 1.f, 1.f, 1.f}; bv[bj][n] = (f32x4){0.f, 0.f, 0.f, 0.f};
                if (!resf) { gv[bj][n] = *(const f32x4*)(gb + col0 + bj * 32 + n * 4); bv[bj][n] = *(const f32x4*)(gb + 1024 + col0 + bj * 32 + n * 4); } }
        int frl = fr; asm volatile("" : "+v"(frl));
        const bool odd = frl & 1;
        const int colw = u.pn * BM + wc * 64 + (frl & 1) * 32 + 8 * fq;
        u32x4 rwq[3][2]; f32x2 stq[3];
#define EPIRES_REQ(i_) do { const int row_ = u.pm * BM + ((i_) >> 2) * HALF + wr * 64 + ((i_) & 3) * 16 + frl; const size_t off_ = (size_t)(row_ - (frl & 1)) * ldc + colw; \
            if (!resf) { stq[(i_) % 3] = *(const f32x2*)(st_in + (size_t)row_ * 8 + 2 * fq); \
                rwq[(i_) % 3][0] = *(const u32x4*)(xb + off_); rwq[(i_) % 3][1] = *(const u32x4*)(xb + off_ + ldc); } } while (0)
        EPIRES_REQ(0); EPIRES_REQ(1);
        PG8_LAS f32x2* const Pl = P + (wr * 64 + frl) * 4 + wc;
#pragma unroll
        for (int i = 0; i < 8; ++i) { const int ai = i >> 2, m = i & 3;
            const int rl = ai * HALF + wr * 64 + m * 16 + frl, row = u.pm * BM + rl; const size_t off = (size_t)row * ldc + col0;
            if (i + 2 < 8) EPIRES_REQ(i + 2);
            float mu = 0.f, rs = 1.f; if (!resf) row_stats_finish(stq[i % 3], mu, rs, fr + 16 * fq);
            u32x4 own[2];
            if (!resf) {
#pragma unroll
                for (int e = 0; e < 4; ++e) { const unsigned a_ = rwq[i % 3][0][e], b_ = rwq[i % 3][1][e]; const unsigned snd = odd ? a_ : b_;
                    const unsigned rcv = (unsigned)__builtin_amdgcn_update_dpp(0, (int)snd, 0xB1, 0xF, 0xF, true);
                    own[0][e] = odd ? rcv : a_; own[1][e] = odd ? b_ : rcv; }
            }
            float s = 0.f, ss = 0.f; u32x4 wo[2];
#pragma unroll
            for (int bj = 0; bj < 2; ++bj) {
#pragma unroll
                for (int n = 0; n < 2; ++n) { f32x4 r;
                    if (resf) r = *(const f32x4*)(resf + off + bj * 32 + n * 4);
                    else { const unsigned w0 = own[bj][2 * n], w1 = own[bj][2 * n + 1];
                           r[0] = __builtin_bit_cast(float, w0 << 16); r[1] = __builtin_bit_cast(float, w0 & 0xffff0000u); r[2] = __builtin_bit_cast(float, w1 << 16); r[3] = __builtin_bit_cast(float, w1 & 0xffff0000u); }
                    const f32x4 h = (r - mu) * rs * gv[bj][n] + bv[bj][n];
                    const f32x4 y = h * alpha + acc[ai][bj][m][n];
                    const unsigned p0 = cvt_pk_bf16(y[0], y[1]), p1 = cvt_pk_bf16(y[2], y[3]); wo[bj][2 * n] = p0; wo[bj][2 * n + 1] = p1;
                    const float y0 = __builtin_bit_cast(float, p0 << 16), y1 = __builtin_bit_cast(float, p0 & 0xffff0000u), y2 = __builtin_bit_cast(float, p1 << 16), y3 = __builtin_bit_cast(float, p1 & 0xffff0000u);
                    s += (y0 + y1) + (y2 + y3); ss += (y0 * y0 + y1 * y1) + (y2 * y2 + y3 * y3); } }
            { u32x4 wa, wb;
#pragma unroll
              for (int e = 0; e < 4; ++e) { const unsigned snd = odd ? wo[0][e] : wo[1][e];
                  const unsigned rcv = (unsigned)__builtin_amdgcn_update_dpp(0, (int)snd, 0xB1, 0xF, 0xF, true);
                  wa[e] = odd ? rcv : wo[0][e]; wb[e] = odd ? wo[1][e] : rcv; }
              bf16_t* wp = xb + (size_t)(row - (frl & 1)) * ldc + colw;
              *(u32x4*)wp = wa; *(u32x4*)(wp + ldc) = wb; }
            s += shx(s, 16, fr + 16 * fq); s += shx(s, 32, fr + 16 * fq); ss += shx(ss, 16, fr + 16 * fq); ss += shx(ss, 32, fr + 16 * fq);
            if (fq == 0) Pl[(ai * HALF + m * 16) * 4] = (f32x2){s, ss}; }
#undef EPIRES_REQ
        asm volatile("s_waitcnt lgkmcnt(0)" ::: "memory"); __builtin_amdgcn_s_barrier(); asm volatile("" ::: "memory");
        asm volatile("" : "+v"(tid));
        if (tid < 256) { const f32x2 a = P[tid * 4 + 0], b = P[tid * 4 + 1], c = P[tid * 4 + 2], d = P[tid * 4 + 3];
            *(f32x2*)(st_out + (size_t)(u.pm * BM + tid) * 8 + 2 * u.pn) = (f32x2){(a[0] + b[0]) + (c[0] + d[0]), (a[1] + b[1]) + (c[1] + d[1])}; }
    }
};
template <class Epi, class Sched, bool ALIGN_EPI = false, bool SP2 = false>
__device__ __forceinline__ void gemm_phase(PG8_LAS unsigned char* lds, const Gemm g, const Sched& S, const Epi& E, int wave_id) {
    unsigned mk_ = ~0u; asm volatile("" : "+s"(mk_)); int lane_ = (int)__builtin_amdgcn_mbcnt_hi(mk_, __builtin_amdgcn_mbcnt_lo(mk_, 0u)); asm volatile("" : "+v"(lane_)); asm volatile("" : "+s"(wave_id));
    const int tid = wave_id * 64 + lane_, wid = wave_id, lane = tid & 63, wr = wid >> 2, wc = wid & 3, fr = lane & 15, fq = lane >> 4;
    const int K = g.K, nt = K / BK;
    unsigned voffA[2], voffB[2];
#pragma unroll
    for (int i = 0; i < 2; ++i) { int R, C; stage_rc(tid * 16 + i * 8192, R, C); const int r5 = Epi::PERM ? perm32(R & 31) : (R & 31); const int Rb = Epi::CONTIG ? ((R >> 5) * 64 + r5) : ((R & ~31) + r5);
        voffA[i] = (unsigned)(R * K + C) * 2u; voffB[i] = (unsigned)(Rb * K + C) * 2u; }
    const size_t kstep = (size_t)(BK * 2);
    const size_t hstep = (size_t)HALF * K * 2;
    const size_t hstepB = Epi::CONTIG ? (size_t)32 * K * 2 : hstep;
    const size_t tstep = 2 * hstep;
    const unsigned ldsw = (unsigned)wid * 1024u;
    const int aoff = lds_byte(wr * 64 + fr, fq * 8), boff = lds_byte(wc * 32 + fr, fq * 8);
#define PG8_SA(b, h) (((b) * 2 + (h)) * HTB)
#define PG8_SB(b, h) ((4 + (b) * 2 + (h)) * HTB)
#define PG8_STAGE(bufoff, gbase, voff) do { _Pragma("unroll") for (int _i = 0; _i < 2; ++_i) \
        __builtin_amdgcn_global_load_lds((const unsigned*)((const char*)(gbase) + (voff)[_i]), (PG8_LAS unsigned*)(lds + (bufoff) + ldsw + _i * 8192), 16, 0, 0); } while (0)
#define PG8_LDA(dst, b, h) do { _Pragma("unroll") for (int m = 0; m < 4; ++m) _Pragma("unroll") for (int k = 0; k < 2; ++k) dst[m][k] = *(const PG8_LAS bf16x8*)(lds + PG8_SA(b, h) + aoff + m * 2048 + k * 1024); } while (0)
#define PG8_LDB(dst, b, h) do { _Pragma("unroll") for (int n = 0; n < 2; ++n) _Pragma("unroll") for (int k = 0; k < 2; ++k) dst[n][k] = *(const PG8_LAS bf16x8*)(lds + PG8_SB(b, h) + boff + n * 2048 + k * 1024); } while (0)
#define PG8_MMA(ai, bj, At, Bt) do { __builtin_amdgcn_s_setprio(1); _Pragma("unroll") for (int m = 0; m < 4; ++m) _Pragma("unroll") for (int n = 0; n < 2; ++n) _Pragma("unroll") for (int k = 0; k < 2; ++k) \
        acc[ai][bj][m][n] = __builtin_amdgcn_mfma_f32_16x16x32_bf16(Bt[n][k], At[m][k], acc[ai][bj][m][n], 0, 0, 0); __builtin_amdgcn_s_setprio(0); } while (0)
#define PG8_WAIT_V(n) asm volatile("s_waitcnt vmcnt(" #n ")" ::: "memory")
#define PG8_WAIT_L(n) asm volatile("s_waitcnt lgkmcnt(" #n ")" ::: "memory")
#define PG8_BAR __builtin_amdgcn_s_barrier()
#define PG8_SCHED __builtin_amdgcn_sched_barrier(0)
    Unit cur, nxt; int ui = 0;
    if (!S.next(0, cur)) return;
    f32x4 acc[2][2][4][2];
#pragma unroll
    for (int a = 0; a < 2; ++a)
#pragma unroll
        for (int b = 0; b < 2; ++b)
#pragma unroll
            for (int m = 0; m < 4; ++m)
#pragma unroll
                for (int n = 0; n < 2; ++n) acc[a][b][m][n] = (f32x4){0.f, 0.f, 0.f, 0.f};
    bf16x8 At[4][2], B0[2][2], B1[2][2];
    const char* cA = (const char*)g.A + (size_t)cur.pm * tstep + (size_t)(cur.pm >> 4) * g.apad; const char* cB = (const char*)g.Bt + (size_t)cur.pn * tstep;
    S.a_ready(cur);
    if constexpr (SP2) {
        PG8_STAGE(PG8_SB(0, 0), cB, voffB); PG8_STAGE(PG8_SB(0, 1), cB + hstepB, voffB); PG8_STAGE(PG8_SA(0, 0), cA, voffA); PG8_STAGE(PG8_SA(0, 1), cA + hstep, voffA);
        if (wr == 1) PG8_BAR;
        PG8_WAIT_V(2); PG8_BAR;
        PG8_STAGE(PG8_SB(1, 0), cB + kstep, voffB); PG8_STAGE(PG8_SA(1, 0), cA + kstep, voffA); PG8_STAGE(PG8_SB(1, 1), cB + hstepB + kstep, voffB);
        PG8_WAIT_V(6); PG8_BAR;
    } else {
        PG8_STAGE(PG8_SB(0, 0), cB, voffB); PG8_STAGE(PG8_SA(0, 0), cA, voffA); PG8_STAGE(PG8_SB(0, 1), cB + hstepB, voffB); PG8_STAGE(PG8_SA(0, 1), cA + hstep, voffA);
        if (wr == 1) PG8_BAR;
        PG8_WAIT_V(4); PG8_BAR;
        PG8_STAGE(PG8_SB(1, 0), cB + kstep, voffB); PG8_STAGE(PG8_SA(1, 0), cA + kstep, voffA); PG8_STAGE(PG8_SB(1, 1), cB + hstepB + kstep, voffB);
        PG8_WAIT_V(6); PG8_BAR;
    }
    for (;;) {
        const bool has_next = S.next(ui + 1, nxt);
        const char* nA = has_next ? (const char*)g.A + (size_t)nxt.pm * tstep + (size_t)(nxt.pm >> 4) * g.apad : cA; const char* nB = has_next ? (const char*)g.Bt + (size_t)nxt.pn * tstep : cB;
        for (int t = 0; t < nt; t += 2) {
            const bool last = (t == nt - 2);
            const char* a1 = cA + (size_t)(t + 1) * kstep;
            const char* a2 = last ? nA : cA + (size_t)(t + 2) * kstep; const char* b2 = last ? nB : cB + (size_t)(t + 2) * kstep;
            const char* a3 = a2 + kstep; const char* b3 = b2 + kstep;
            if (last && has_next) S.a_ready(nxt);
            if constexpr (SP2) {
            PG8_LDB(B0, 0, 0); PG8_LDB(B1, 0, 1); PG8_SCHED; PG8_LDA(At, 0, 0); PG8_STAGE(PG8_SA(1, 1), a1 + hstep, voffA);
            PG8_WAIT_V(8); PG8_WAIT_L(0); PG8_BAR; PG8_MMA(0, 0, At, B0); PG8_MMA(0, 1, At, B1); PG8_BAR; PG8_SCHED;
            PG8_LDA(At, 0, 1); PG8_STAGE(PG8_SB(0, 0), b2, voffB); PG8_STAGE(PG8_SB(0, 1), b2 + hstepB, voffB); PG8_STAGE(PG8_SA(0, 0), a2, voffA);
            PG8_WAIT_V(8); PG8_WAIT_L(0); PG8_BAR; PG8_MMA(1, 0, At, B0); PG8_MMA(1, 1, At, B1); PG8_BAR; PG8_SCHED;
            PG8_LDB(B0, 1, 0); PG8_LDB(B1, 1, 1); PG8_SCHED; PG8_LDA(At, 1, 0); PG8_STAGE(PG8_SA(0, 1), a2 + hstep, voffA);
            PG8_WAIT_V(8); PG8_WAIT_L(0); PG8_BAR; PG8_MMA(0, 0, At, B0); PG8_MMA(0, 1, At, B1); PG8_BAR; PG8_SCHED;
            PG8_LDA(At, 1, 1); PG8_STAGE(PG8_SB(1, 0), b3, voffB); PG8_STAGE(PG8_SB(1, 1), b3 + hstepB, voffB); PG8_STAGE(PG8_SA(1, 0), a3, voffA);
            PG8_WAIT_V(8); PG8_WAIT_L(0); PG8_BAR; PG8_MMA(1, 0, At, B0); PG8_MMA(1, 1, At, B1); PG8_BAR; PG8_SCHED;
            } else {
            PG8_LDB(B0, 0, 0); PG8_SCHED; PG8_LDA(At, 0, 0); PG8_STAGE(PG8_SA(1, 1), a1 + hstep, voffA);
            PG8_WAIT_L(8); PG8_BAR; PG8_WAIT_L(0); PG8_MMA(0, 0, At, B0); PG8_BAR; PG8_SCHED;
            PG8_LDB(B1, 0, 1); PG8_STAGE(PG8_SB(0, 0), b2, voffB);
            PG8_BAR; PG8_WAIT_L(0); PG8_MMA(0, 1, At, B1); PG8_BAR;
            PG8_LDA(At, 0, 1); PG8_STAGE(PG8_SA(0, 0), a2, voffA);
            PG8_BAR; PG8_WAIT_L(0); PG8_MMA(1, 0, At, B0); PG8_BAR; PG8_SCHED;
            PG8_STAGE(PG8_SB(0, 1), b2 + hstepB, voffB);
            PG8_WAIT_V(6); PG8_BAR; PG8_MMA(1, 1, At, B1); PG8_BAR;
            PG8_LDB(B0, 1, 0); PG8_SCHED; PG8_LDA(At, 1, 0); PG8_STAGE(PG8_SA(0, 1), a2 + hstep, voffA);
            PG8_WAIT_L(8); PG8_BAR; PG8_WAIT_L(0); PG8_MMA(0, 0, At, B0); PG8_BAR; PG8_SCHED;
            PG8_LDB(B1, 1, 1); PG8_STAGE(PG8_SB(1, 0), b3, voffB);
            PG8_BAR; PG8_WAIT_L(0); PG8_MMA(0, 1, At, B1); PG8_BAR;
            PG8_LDA(At, 1, 1); PG8_STAGE(PG8_SA(1, 0), a3, voffA);
            PG8_BAR; PG8_WAIT_L(0); PG8_MMA(1, 0, At, B0); PG8_BAR; PG8_SCHED;
            PG8_STAGE(PG8_SB(1, 1), b3 + hstepB, voffB);
            PG8_WAIT_V(6); PG8_BAR; PG8_MMA(1, 1, At, B1); PG8_BAR;
            }
        }
        if constexpr (ALIGN_EPI) { if (wr == 0) PG8_BAR; }
        if constexpr (!Epi::AFTER_DRAIN) { E(acc, cur, wr, wc, fr, fq, lds, tid); S.done(cur); }
        if (!has_next) break;
#pragma unroll
        for (int a = 0; a < 2; ++a)
#pragma unroll
            for (int b = 0; b < 2; ++b)
#pragma unroll
                for (int m = 0; m < 4; ++m)
#pragma unroll
                    for (int n = 0; n < 2; ++n) acc[a][b][m][n] = (f32x4){0.f, 0.f, 0.f, 0.f};
        cur = nxt; cA = nA; cB = nB; ++ui;
        if constexpr (ALIGN_EPI) { if (wr == 1) PG8_BAR; }
    }
    PG8_WAIT_V(0);
    if constexpr (!ALIGN_EPI) { if (wr == 0) PG8_BAR; }
    PG8_BAR;
    if constexpr (Epi::AFTER_DRAIN) { E.fused(acc, cur, wr, wc, fr, fq, lds, wid, lane); S.done(cur); }
#undef PG8_SA
#undef PG8_SB
#undef PG8_STAGE
#undef PG8_LDA
#undef PG8_LDB
#undef PG8_MMA
#undef PG8_WAIT_V
#undef PG8_WAIT_L
#undef PG8_BAR
#undef PG8_SCHED
}
}

constexpr int NWAVES = 8;
constexpr int BATCH = 16, SEQ = 2048, D = 1024, DEPTH = 4, T = BATCH * SEQ;
constexpr int P_IN = 2594, NPROJ = 2816, FF = 4096;
constexpr int C_Q = 0, C_KV = 384, C_GQ = 1152, C_GK = 1344, C_GV = 1536, C_OG = 1920, C_PU = 2304, C_GLR = 2560, C_GATE = 2576;
constexpr float LN_EPS = 1e-5f, RMS_EPS = 1e-6f;
constexpr float ALPHA = 1.6817928305074290f;
constexpr float QSCALE = 0.125f * 1.4426950408889634f;

constexpr size_t MiB = 1u << 20, KiB = 1u << 10;
constexpr size_t WS_CTL = 0, CTL_ZERO_BYTES = 1 * MiB;
constexpr size_t WS_CV = 3 * MiB;
constexpr size_t CV_C1IN = 0, CV_C2IN = 4 * 2816, CV_C1UP = 8 * 2816, CV_C2UP = 8 * 2816 + 4 * 4096;
constexpr size_t WS_ROPE = 4 * MiB;
constexpr size_t WS_BIAS1 = 4 * MiB + 128 * KiB;
constexpr size_t WS_W2G = 4 * MiB + 192 * KiB;
constexpr size_t WS_WP = 4 * MiB + 256 * KiB;
constexpr size_t WS_W2C = 4 * MiB + 384 * KiB;
constexpr size_t WS_GB = 4 * MiB + 448 * KiB;
constexpr size_t WS_W1C = 5 * MiB;
constexpr size_t WS_WIN = 7 * MiB;
constexpr size_t WS_WOUT = 29 * MiB;
constexpr size_t WS_WUP = 37 * MiB;
constexpr size_t WS_WDN = 69 * MiB;
constexpr size_t WS_KC = 101 * MiB;
constexpr size_t WS_VC = 101 * MiB + 512 * KiB;
constexpr size_t WS_DECAY = 102 * MiB;
constexpr size_t WS_DST = 103 * MiB;
constexpr size_t WS_XN = 127 * MiB;
constexpr size_t WS_R = 191 * MiB;
constexpr size_t WS_MIXED = WS_R + 22 * MiB, SLAB_PADP = 10 * MiB, SLAB_PADM = 24 * MiB;
constexpr size_t WS_ST = 447 * MiB;
constexpr size_t WS_VT = 455 * MiB;
constexpr size_t WS_QK = 471 * MiB;
constexpr size_t WS_CP = 495 * MiB;
constexpr size_t CP_UP = (size_t)3 * 2 * 16 * 2816;
constexpr size_t WS_END = 499 * MiB;
static_assert(WS_CV + (8 * 2816 + 8 * 4096) * 4 <= WS_ROPE && WS_WIN + (size_t)DEPTH * NPROJ * D * 2 <= WS_WOUT && WS_DST + (size_t)16 * 6 * 32 * 32 * 64 * 4 <= WS_XN && (size_t)4096 * NPROJ * 2 <= 22 * MiB && (size_t)4096 * D * 2 <= 8 * MiB && (size_t)4096 * FF * 2 == 32 * MiB && WS_R + 8 * 32 * MiB <= WS_ST && WS_ST + (size_t)2 * T * 32 * 4 <= WS_VT && WS_VT + (size_t)16 * 2 * 2 * 64 * 2048 * 2 <= WS_QK && WS_QK + (size_t)T * 384 * 2 <= WS_CP && WS_CP + (CP_UP + (size_t)4 * 2 * 16 * 4096) * 4 <= WS_END, "d_ws map");
constexpr int CW_BAR = 4096;

constexpr int SCR_BYTES = 143360;
constexpr int LDSCTL_OFF = SCR_BYTES;
constexpr int LDS_BYTES = 147456;

#define GAS __attribute__((address_space(1)))
#define LAS __attribute__((address_space(3)))
typedef unsigned short bf16;
typedef unsigned v4u __attribute__((ext_vector_type(4)));
typedef unsigned v2u __attribute__((ext_vector_type(2)));
typedef float f32x4 __attribute__((ext_vector_type(4)));
typedef float f32x16 __attribute__((ext_vector_type(16)));
typedef short bf16x8 __attribute__((ext_vector_type(8)));
#define LDS_WAIT() asm volatile("s_waitcnt lgkmcnt(0)" ::: "memory")
#define VM_WAIT() asm volatile("s_waitcnt vmcnt(0)" ::: "memory")
typedef float f32x2_t __attribute__((ext_vector_type(2))); typedef __bf16 bf16x2_t __attribute__((ext_vector_type(2)));
__device__ __forceinline__ unsigned pk2(float lo, float hi) { const f32x2_t v = {lo, hi}; const bf16x2_t b = __builtin_convertvector(v, bf16x2_t); return __builtin_bit_cast(unsigned, b); }
__device__ __forceinline__ unsigned f2bf(float f) { return pk2(f, 0.f) & 0xffffu; }
__device__ __forceinline__ float bf2f(unsigned b) { return __builtin_bit_cast(float, b << 16); }
__device__ __forceinline__ float bflo(unsigned w) { return __builtin_bit_cast(float, w << 16); }
__device__ __forceinline__ float bfhi(unsigned w) { return __builtin_bit_cast(float, w & 0xffff0000u); }
__device__ __forceinline__ f32x4 mma16(bf16x8 a, bf16x8 b, f32x4 c) { return __builtin_amdgcn_mfma_f32_16x16x32_bf16(a, b, c, 0, 0, 0); }
__device__ __forceinline__ f32x16 mma32(bf16x8 a, bf16x8 b, f32x16 c) { return __builtin_amdgcn_mfma_f32_32x32x16_bf16(a, b, c, 0, 0, 0); }
__device__ __forceinline__ float ex2(float x) { return __builtin_amdgcn_exp2f(x); }
__device__ __forceinline__ float fexp(float x) { return __builtin_amdgcn_exp2f(x * 1.4426950408889634f); }
__device__ __forceinline__ float sigmoidf_(float x) { return __builtin_amdgcn_rcpf(1.0f + fexp(-x)); }
__device__ __forceinline__ bf16x8 as_bf16x8(v4u v) { return __builtin_bit_cast(bf16x8, v); }
#define XB_TMO      128
#define XB_XCNT(j)  (256  + 64 * (j))
#define XB_XSUB(j)  (1280 + 64 * (j))
#define XB_XGEN(j)  (2304 + 64 * (j))
#define XB_TOP      3328
#define XB_TOPGEN   3392
#define XB_LSUB(j)  (3456 + 64 * (j))
#define XB_LGEN(j)  (4480 + 64 * (j))
#define XCD_BAR_WORDS 5504
#define XB_SPIN_CAP (1u << 18)

__device__ __forceinline__ unsigned xb_ld(unsigned* p)              { return __hip_atomic_load(p, __ATOMIC_RELAXED, __HIP_MEMORY_SCOPE_AGENT); }
__device__ __forceinline__ unsigned xb_add(unsigned* p, unsigned v) { return __hip_atomic_fetch_add(p, v, __ATOMIC_RELAXED, __HIP_MEMORY_SCOPE_AGENT); }
__device__ __forceinline__ unsigned xb_xcc_id() { return (unsigned)__builtin_amdgcn_s_getreg((3 << 11) | 20) & 0xFu; }
#define XB_SPIN(cond, bar) do { unsigned _sp = 0; while (cond) { __builtin_amdgcn_s_sleep(1); \
    if ((++_sp & 255u) == 0u) { if (xb_ld(&(bar)[XB_TMO])) break; if (_sp > XB_SPIN_CAP) { atomicAdd(&(bar)[XB_TMO], 1u); break; } } } } while (0)

struct XcdBarrier {
    unsigned* bar; unsigned x;
    volatile LAS unsigned* st;
};

__device__ __forceinline__ XcdBarrier xcd_barrier_post(unsigned* bar, volatile LAS unsigned* st) {
    XcdBarrier b; b.bar = bar; b.x = xb_xcc_id(); b.st = st;
    if (threadIdx.x == 0) st[2] = xb_add(&bar[XB_XCNT(b.x)], 1u);
    return b;
}
__device__ __forceinline__ void xcd_barrier_complete(unsigned* bar, unsigned x, unsigned& nloc, unsigned& nx) {
    const unsigned G = gridDim.x * gridDim.y * gridDim.z;
    unsigned sum, cnt, mine, sp = 0u;
    for (;;) {
        sum = 0u; cnt = 0u; mine = 0u;
#pragma unroll
        for (unsigned j = 0; j < 16; ++j) { const unsigned c = xb_ld(&bar[XB_XCNT(j)]); sum += c; cnt += (c > 0u) ? 1u : 0u; mine = (j == x) ? c : mine; }
        if (sum == G) break;
        __builtin_amdgcn_s_sleep(1);
        if ((++sp & 255u) == 0u) { if (xb_ld(&bar[XB_TMO])) break; if (sp > XB_SPIN_CAP) { atomicAdd(&bar[XB_TMO], 1u); break; } }
    }
    nloc = mine > 0u ? mine : 1u; nx = cnt > 0u ? cnt : 1u;
}

__device__ __forceinline__ void xcd_barrier(const XcdBarrier& b, const bool leader_thread  ) {
    asm volatile("s_waitcnt vmcnt(0)" ::: "memory");
    __syncthreads();
    if (leader_thread) {
        unsigned* bar = b.bar;
        __builtin_amdgcn_s_waitcnt(0);
        unsigned nloc = b.st[0], nx = b.st[1];
        if (nloc == 0u) { xcd_barrier_complete(bar, b.x, nloc, nx); b.st[0] = nloc; b.st[1] = nx; }
        const unsigned old = xb_add(&bar[XB_XSUB(b.x)], 1u);
        const unsigned gen = old / nloc;
        if (old + 1u == (gen + 1u) * nloc) {
            __builtin_amdgcn_fence(__ATOMIC_RELEASE, "agent");
            asm volatile("s_waitcnt vmcnt(0)" ::: "memory");
            const unsigned og = xb_add(&bar[XB_TOP], 1u);
            const unsigned tg = og / nx;
            if (og + 1u == (tg + 1u) * nx) xb_add(&bar[XB_TOPGEN], 1u);
            else XB_SPIN(xb_ld(&bar[XB_TOPGEN]) == tg, bar);
            __builtin_amdgcn_fence(__ATOMIC_ACQUIRE, "agent");
            xb_add(&bar[XB_XGEN(b.x)], 1u);
            asm volatile("s_waitcnt vmcnt(0)" ::: "memory");
        } else {
            XB_SPIN(xb_ld(&bar[XB_XGEN(b.x)]) == gen, bar);
            __builtin_amdgcn_fence(__ATOMIC_ACQUIRE, "agent");
            asm volatile("s_waitcnt vmcnt(0)" ::: "memory");
        }
    }
    __syncthreads();
}

__device__ __forceinline__ void xcd_barrier_local(const XcdBarrier& b, const bool leader_thread) {
    asm volatile("s_waitcnt vmcnt(0)" ::: "memory");
    __syncthreads();
    if (leader_thread) {
        unsigned* bar = b.bar;
        __builtin_amdgcn_s_waitcnt(0);
        const unsigned nloc = b.st[0];
        const unsigned old = xb_add(&bar[XB_LSUB(b.x)], 1u);
        const unsigned gen = old / nloc;
        if (old + 1u == (gen + 1u) * nloc) {
            __builtin_amdgcn_fence(__ATOMIC_RELEASE, "agent");
            asm volatile("s_waitcnt vmcnt(0)" ::: "memory");
            xb_add(&bar[XB_LGEN(b.x)], 1u);
            __builtin_amdgcn_fence(__ATOMIC_ACQUIRE, "agent");
            asm volatile("s_waitcnt vmcnt(0)" ::: "memory");
        } else {
            XB_SPIN(xb_ld(&bar[XB_LGEN(b.x)]) == gen, bar);
            __builtin_amdgcn_fence(__ATOMIC_ACQUIRE, "agent");
            asm volatile("s_waitcnt vmcnt(0)" ::: "memory");
        }
    }
    __syncthreads();
}
__device__ __forceinline__ int xcd_local_id(const XcdBarrier& b, unsigned G) {
    unsigned nx = 0u, xidx = 0u; bool even = (G == 256u);
#pragma unroll
    for (unsigned j = 0; j < 16; ++j) { const unsigned c = xb_ld(&b.bar[XB_XCNT(j)]); if (c) { if (c != 32u) even = false; if (j < b.x) ++xidx; ++nx; } }
    const unsigned rank = b.st[2];
    return (even && nx == 8u && rank < 32u) ? (int)(rank * 8u + xidx) : -1;
}

struct Frame { LAS unsigned char* lds; int tid, lane, wave, G, bid, wave0, cid, lok; };
#define FRAME_REFRESH(F) do { int w_ = (F).wave0; asm volatile("" : "+s"(w_)); unsigned m_ = ~0u; asm volatile("" : "+s"(m_)); int l_ = (int)__builtin_amdgcn_mbcnt_hi(m_, __builtin_amdgcn_mbcnt_lo(m_, 0u)); asm volatile("" : "+v"(l_)); int b_ = (F).cid; asm volatile("" : "+s"(b_)); (F).tid = w_ * 64 + l_; (F).lane = l_; (F).wave = w_; (F).bid = b_; } while (0)
struct Args { const float* in[17]; float* out; unsigned char* ws; int ph_lo, ph_hi; };
static_assert(sizeof(Args) == 19 * 8 + 8, "Args has no padding");
__device__ __forceinline__ const unsigned char* karg_ptr(int idx) {
    unsigned long long base = (unsigned long long)__builtin_amdgcn_kernarg_segment_ptr();
    asm volatile("" : "+s"(base));
    const unsigned long long v = ((const __attribute__((address_space(4))) unsigned long long*)base)[idx];
    return (const unsigned char*)(const __attribute__((address_space(1))) unsigned char*)v;
}
#define P_IN_(i) ((const float*)karg_ptr(i))
#define P_x P_IN_(0)
#define P_w_in P_IN_(1)
#define P_cmp_pos P_IN_(2)
#define P_cmp_w1 P_IN_(3)
#define P_cmp_w2 P_IN_(4)
#define P_gla_w2 P_IN_(5)
#define P_gla_b P_IN_(6)
#define P_gla_ng P_IN_(7)
#define P_pool_w P_IN_(8)
#define P_pool_s P_IN_(9)
#define P_w_out P_IN_(10)
#define P_ln1_g P_IN_(11)
#define P_ln1_b P_IN_(12)
#define P_w_up P_IN_(13)
#define P_w_down P_IN_(14)
#define P_ln2_g P_IN_(15)
#define P_ln2_b P_IN_(16)
#define P_H ((float*)karg_ptr(17))
#define P_WS ((unsigned char*)karg_ptr(18))
#define P_rope ((float*)(P_WS + WS_ROPE))
#define P_bias1 ((float*)(P_WS + WS_BIAS1))
#define P_decay ((float*)(P_WS + WS_DECAY))
#define P_dst ((float*)(P_WS + WS_DST))
#define P_W2G ((bf16*)(P_WS + WS_W2G))
#define P_WP ((bf16*)(P_WS + WS_WP))
#define P_W2C ((bf16*)(P_WS + WS_W2C))
#define P_W1C ((bf16*)(P_WS + WS_W1C))
#define P_WIN ((bf16*)(P_WS + WS_WIN))
#define P_WOUT ((bf16*)(P_WS + WS_WOUT))
#define P_WUP ((bf16*)(P_WS + WS_WUP))
#define P_WDN ((bf16*)(P_WS + WS_WDN))
#define P_KC ((bf16*)(P_WS + WS_KC))
#define P_VC ((bf16*)(P_WS + WS_VC))
#define P_XN ((bf16*)(P_WS + WS_XN))
#define P_VT ((bf16*)(P_WS + WS_VT))
#define P_QK ((bf16*)(P_WS + WS_QK))
#define P_CP ((float*)(P_WS + WS_CP))
#define P_PROJ ((bf16*)(P_WS + WS_R))
#define P_MIXED ((bf16*)(P_WS + WS_MIXED))
#define P_U ((bf16*)(P_WS + WS_R))
#define P_PROJ_B(b) ((bf16*)(P_WS + WS_R + (size_t)((b) >> 1) * SLAB_PADP))
#define P_MIXED_B(b) ((bf16*)(P_WS + WS_MIXED + (size_t)((b) >> 1) * SLAB_PADM))
#define P_ST(k) ((float*)(P_WS + WS_ST) + (size_t)((k) & 1) * T * 8)
#define P_CV ((float*)(P_WS + WS_CV))
#define P_GB ((float*)(P_WS + WS_GB))
__device__ __forceinline__ float wave_sum(float v, int lane) {
#pragma unroll
    for (int o = 1; o < 64; o <<= 1) v += shx(v, o, lane);
    return v;
}

__device__ __forceinline__ int inproj_src_col(int n) {
    if (n < 1152) return n;
    if (n < 1920) return n + 18;
    if (n < 2560) return n + 34;
    if (n < 2576) return 1938 + (n - 2560);
    if (n < 2594) return 1152 + (n - 2576);
    return -1;
}
template <bool MAPIN, bool FOLD>
__device__ __forceinline__ void transpose_item(const float* W, int K, int Nsrc, bf16* WT, LAS float* scr, int kb, int nb, int lane, const float* gam = nullptr, const float* bet = nullptr, float* cp1 = nullptr, float* cp2 = nullptr) {
    typedef float f32x2t __attribute__((ext_vector_type(2)));
    const int k0 = 64 * kb, n0 = 64 * nb, cp = lane & 31, kh = lane >> 5;
    int sc = n0 + 2 * cp; if (MAPIN) sc = inproj_src_col(sc);
    f32x2t a1 = (f32x2t){0.f, 0.f}, a2 = a1;
#pragma unroll 1
    for (int hb = 0; hb < 2; ++hb) {
        f32x2t wv[16]; float gg[FOLD ? 16 : 1], bb[FOLD ? 16 : 1];
#pragma unroll
        for (int i = 0; i < 16; ++i) { const int kk = 2 * (16 * hb + i) + kh; wv[i] = (f32x2t){0.f, 0.f};
            if (sc >= 0) wv[i] = *(const f32x2t*)(W + (size_t)(k0 + kk) * Nsrc + sc);
            if (FOLD) { gg[i] = gam[k0 + kk]; bb[i] = bet[k0 + kk]; } }
#pragma unroll
        for (int i = 0; i < 16; ++i) { const int kk = 2 * (16 * hb + i) + kh; f32x2t w = wv[i];
            if (FOLD) { a2 = a2 + w * bb[i]; w = w * gg[i]; a1[0] += bf2f(f2bf(w[0])); a1[1] += bf2f(f2bf(w[1])); }
            scr[kk * 65 + 2 * cp] = w[0]; scr[kk * 65 + 2 * cp + 1] = w[1]; }
    }
    if (FOLD) { a1[0] += shx(a1[0], 32, lane); a1[1] += shx(a1[1], 32, lane); a2[0] += shx(a2[0], 32, lane); a2[1] += shx(a2[1], 32, lane);
        if (kh == 0) { *(f32x2t*)(cp1 + n0 + 2 * cp) = a1; *(f32x2t*)(cp2 + n0 + 2 * cp) = a2; } }
    LDS_WAIT(); asm volatile("" ::: "memory");
    const int c = lane & 7;
#pragma unroll
    for (int j = 0; j < 8; ++j) { const int n = (lane >> 3) + 8 * j; const LAS float* s = scr + (8 * c) * 65 + n;
        v4u o; o.x = pk2(s[0 * 65], s[1 * 65]); o.y = pk2(s[2 * 65], s[3 * 65]); o.z = pk2(s[4 * 65], s[5 * 65]); o.w = pk2(s[6 * 65], s[7 * 65]);
        *(v4u*)(WT + (size_t)(n0 + n) * K + k0 + 8 * c) = o; }
    LDS_WAIT(); asm volatile("" ::: "memory");
}

__device__ __forceinline__ void p0_prologue(Frame& F) {
    LAS float* scr = (LAS float*)(F.lds + F.wave * 16640);
    const int gw = F.bid * NWAVES + F.wave, NGW = F.G * NWAVES;
    constexpr int I_IN = (D / 64) * (NPROJ / 64), I_OUT = (D / 64) * (D / 64), I_UP = (D / 64) * (FF / 64), I_DN = (FF / 64) * (D / 64), I_C1 = 2 * 32, I_C2 = 2, I_WP = 4;
    constexpr int I_LAYER = I_IN + I_OUT + I_UP + I_DN + I_C1 + I_C2 + I_WP;
    for (int it = gw; it < DEPTH * I_LAYER; it += NGW) {
        const int l = it / I_LAYER; int r = it % I_LAYER;
        if (r < I_IN) { if (l == 0) transpose_item<true, false>(P_w_in, D, P_IN, P_WIN, scr, r / (NPROJ / 64), r % (NPROJ / 64), F.lane);
                         else transpose_item<true, true>(P_w_in + (size_t)l * D * P_IN, D, P_IN, P_WIN + (size_t)l * NPROJ * D, scr, r / (NPROJ / 64), r % (NPROJ / 64), F.lane, P_ln2_g + (l - 1) * D, P_ln2_b + (l - 1) * D,
                                                        P_CP + ((size_t)((l - 1) * 2 + 0) * 16 + r / (NPROJ / 64)) * NPROJ, P_CP + ((size_t)((l - 1) * 2 + 1) * 16 + r / (NPROJ / 64)) * NPROJ);
                         continue; } r -= I_IN;
        if (r < I_OUT) { transpose_item<false, false>(P_w_out + (size_t)l * D * D, D, D, P_WOUT + (size_t)l * D * D, scr, r / (D / 64), r % (D / 64), F.lane); continue; } r -= I_OUT;
        if (r < I_UP) { transpose_item<false, true>(P_w_up + (size_t)l * D * FF, D, FF, P_WUP + (size_t)l * D * FF, scr, r / (FF / 64), r % (FF / 64), F.lane, P_ln1_g + l * D, P_ln1_b + l * D,
                                                      P_CP + CP_UP + ((size_t)(l * 2 + 0) * 16 + r / (FF / 64)) * FF, P_CP + CP_UP + ((size_t)(l * 2 + 1) * 16 + r / (FF / 64)) * FF); continue; } r -= I_UP;
        if (r < I_DN) { transpose_item<false, false>(P_w_down + (size_t)l * D * FF, FF, D, P_WDN + (size_t)l * D * FF, scr, r / (D / 64), r % (D / 64), F.lane); continue; } r -= I_DN;
        if (r < I_C1) { const int kv = r / 32, rr = r % 32; transpose_item<false, false>(P_cmp_w1 + (size_t)(l * 2 + kv) * 2048 * 64, 2048, 64, P_W1C + (size_t)(l * 2 + kv) * 64 * 2048, scr, rr, 0, F.lane); continue; } r -= I_C1;
        if (r < I_C2) { const int kv = r; transpose_item<false, false>(P_cmp_w2 + (size_t)(l * 2 + kv) * 64 * 64, 64, 64, P_W2C + (size_t)(l * 2 + kv) * 64 * 64, scr, 0, 0, F.lane); continue; } r -= I_C2;
        { const int g = r; transpose_item<false, false>(P_pool_w + (size_t)(l * 4 + g) * 64 * 64, 64, 64, P_WP + (size_t)(l * 4 + g) * 64 * 64, scr, 0, 0, F.lane); }
    }
    for (int task = F.bid + F.G * F.wave; task < DEPTH * 2 * 64; task += NGW) {
        const int lk = task >> 6, j = task & 63; const float* pp = P_cmp_pos + (size_t)lk * 2048; const float* ww = P_cmp_w1 + (size_t)lk * 2048 * 64 + j;
        float s = 0.f;
#pragma unroll 1
        for (int k0 = F.lane; k0 < 2048; k0 += 512) { float pv[8], wv[8];
#pragma unroll
            for (int i = 0; i < 8; ++i) { pv[i] = pp[k0 + 64 * i]; wv[i] = ww[(size_t)(k0 + 64 * i) * 64]; }
#pragma unroll
            for (int i = 0; i < 8; ++i) s += pv[i] * wv[i]; }
        s = wave_sum(s, F.lane);
        if (F.lane == 0) P_bias1[task] = s;
    }
    const int gt = F.bid * (NWAVES * 64) + F.tid, NGT = F.G * NWAVES * 64;
    float* const ropep = P_rope;
    for (int idx = gt; idx < SEQ * 8; idx += NGT) {
        const int pos = idx >> 3, i = idx & 7;
        const float inv = (i == 0) ? 1.0f : (i == 1) ? 0.1939227432012558f : (i == 2) ? 0.03760603070259094f : (i == 3) ? 0.007292664609849453f : (i == 4) ? 0.0014142135623842478f
                        : (i == 5) ? 0.00027424818836152554f : (i == 6) ? 5.318296098266728e-05f : 1.0313386155758053e-05f;
        const float ang = (float)pos * inv;
        double rev = (double)ang * 0.15915494309189535; rev -= __builtin_floor(rev);
        const float rf = (float)rev;
        ropep[pos * 16 + i] = __builtin_amdgcn_cosf(rf); ropep[pos * 16 + 8 + i] = __builtin_amdgcn_sinf(rf);
    }
    for (int idx = gt; idx < 8 * 2048; idx += NGT) { const int k = idx >> 11, c = idx & 1023, isb = (idx >> 10) & 1, l = k >> 1;
        const float* src = (k & 1) ? (isb ? P_ln2_b : P_ln2_g) : (isb ? P_ln1_b : P_ln1_g); P_GB[idx] = src[l * D + c]; }
    { bf16* const w2g = P_W2G; const float* const gw2 = P_gla_w2;
    for (int idx = gt; idx < DEPTH * 192 * 32; idx += NGT) {
        const int k = idx & 31, col = (idx >> 5) % 192, l = idx / (192 * 32);
        w2g[idx] = (k < 16) ? (bf16)f2bf(gw2[(size_t)(l * 16 + k) * 192 + col]) : (bf16)0;
    } }
    { const float* const xin = P_x; bf16* const xn = P_XN;
    const size_t step = (size_t)NGT * 8;
    for (size_t i = (size_t)gt * 8; i < (size_t)T * D; i += 4 * step) {
        f32x4 a[4], b[4];
#pragma unroll
        for (int k = 0; k < 4; ++k) if (i + k * step < (size_t)T * D) { a[k] = *(const f32x4*)(xin + i + k * step); b[k] = *(const f32x4*)(xin + i + k * step + 4); }
#pragma unroll
        for (int k = 0; k < 4; ++k) if (i + k * step < (size_t)T * D) { v4u o; o.x = pk2(a[k][0], a[k][1]); o.y = pk2(a[k][2], a[k][3]); o.z = pk2(b[k][0], b[k][1]); o.w = pk2(b[k][2], b[k][3]);
            *(v4u*)(xn + i + k * step) = o; }
    } }
}

__device__ __forceinline__ void fold_vectors_reduce(Frame& F) {
    const float* const cpb = P_CP; float* const cv = P_CV;
    const int gt = F.bid * (NWAVES * 64) + F.tid, NGT = F.G * NWAVES * 64;
    constexpr int N_IN = 3 * 2 * NPROJ, N_UP = 4 * 2 * FF;
    for (int idx = gt; idx < N_IN + N_UP; idx += NGT) {
        const bool isup = idx >= N_IN; const int e = isup ? idx - N_IN : idx, N = isup ? FF : NPROJ;
        const int lw = e / N, n = e % N, which = lw & 1, l = isup ? (lw >> 1) : 1 + (lw >> 1);
        const float* p = cpb + (isup ? CP_UP : 0) + (size_t)lw * 16 * N + n;
        float s = 0.f;
#pragma unroll
        for (int kb = 0; kb < 16; ++kb) s += p[(size_t)kb * N];
        cv[(isup ? (which ? CV_C2UP : CV_C1UP) + (size_t)l * FF : (which ? CV_C2IN : CV_C1IN) + (size_t)l * NPROJ) + n] = s;
    }
}
__device__ __forceinline__ void final_ln_phase(Frame& F, const float* st, const float* gam, const float* bet) {
    float* const Hp = P_H; const bf16* const XNp = P_XN;
    const int gw = F.bid * NWAVES + F.wave, NGW = F.G * NWAVES;
    f32x4 gv[4], bv[4];
#pragma unroll
    for (int j = 0; j < 4; ++j) { gv[j] = *(const f32x4*)(gam + 4 * F.lane + 256 * j); bv[j] = *(const f32x4*)(bet + 4 * F.lane + 256 * j); }
    v2u w[4], wn[4]; float sv, svn;
#define FLN_REQ(m_, W_, S_) do { const bf16* xr_ = XNp + (size_t)(m_) * D + 4 * F.lane; S_ = (F.lane < 8) ? st[(size_t)(m_) * 8 + F.lane] : 0.f; \
        _Pragma("unroll") for (int j = 0; j < 4; ++j) W_[j] = *(const v2u*)(xr_ + 256 * j); } while (0)
    if (gw < T) FLN_REQ(gw, w, sv);
    for (int m = gw; m < T; m += NGW) {
        const bool more = m + NGW < T;
        if (more) FLN_REQ(m + NGW, wn, svn);
        float* hr = Hp + (size_t)m * D + 4 * F.lane;
        sv += shx(sv, 2, F.lane); sv += shx(sv, 4, F.lane);
        const float s0 = __builtin_bit_cast(float, __builtin_amdgcn_readlane(__builtin_bit_cast(int, sv), 0)), s1 = __builtin_bit_cast(float, __builtin_amdgcn_readlane(__builtin_bit_cast(int, sv), 1));
        const float mu = s0 * (1.0f / 1024.0f), rstd = 1.0f / sqrtf(fmaxf(s1 * (1.0f / 1024.0f) - mu * mu, 0.f) + LN_EPS);
#pragma unroll
        for (int j = 0; j < 4; ++j) { f32x4 v; v[0] = bflo(w[j].x); v[1] = bfhi(w[j].x); v[2] = bflo(w[j].y); v[3] = bfhi(w[j].y); *(f32x4*)(hr + 256 * j) = (v - mu) * rstd * gv[j] + bv[j]; }
        if (more) { sv = svn;
#pragma unroll
            for (int j = 0; j < 4; ++j) w[j] = wn[j]; }
    }
#undef FLN_REQ
}

__device__ __forceinline__ void m1_compress(Frame& F, int l, int unit) {
    const bf16* const W1C = P_W1C; const bf16* const W2C = P_W2C; const float* const bias1 = P_bias1; bf16* const KC = P_KC; bf16* const VC = P_VC;
    const int rb = unit & 3, kv = (unit >> 2) & 1, g = (unit >> 3) & 1, b = unit >> 4;
    const bf16* const PROJ = P_PROJ_B(b);
    LAS bf16* Ts = (LAS bf16*)F.lds;
    LAS bf16* Hs = Ts + 528 * 72;
    const int colsrc = C_KV + ((0 * 2 + kv) * 2 + g) * 64, tok0 = 512 * rb;
    for (int c = F.tid; c < 528 * 8; c += NWAVES * 64) {
        const int r = c >> 3, ch = c & 7, tok = tok0 + r; v4u v = (v4u){0u, 0u, 0u, 0u};
        if (tok < SEQ) v = *(const v4u*)(PROJ + (size_t)(b * SEQ + tok) * NPROJ + colsrc + 8 * ch);
        *(LAS v4u*)(Ts + r * 72 + 8 * ch) = v;
    }
    __syncthreads();
    const int mt = F.wave >> 2, nt = F.wave & 3, fr = F.lane & 15, fq = F.lane >> 4;
    const int lk = l * 2 + kv;
    {
        const bf16* w1t = W1C + ((size_t)lk * 64 + 16 * nt + fr) * 2048 + 8 * fq;
        const LAS bf16* ap = Ts + (16 * (16 * mt + fr)) * 72;
        f32x4 acc = (f32x4){0.f, 0.f, 0.f, 0.f};
#pragma unroll 8
        for (int kk = 0; kk < 64; ++kk) { const int k0 = 32 * kk + 8 * fq;
            const bf16x8 a = *(const LAS bf16x8*)(ap + (k0 >> 6) * 72 + (k0 & 63));
            const bf16x8 w = *(const bf16x8*)(w1t + 32 * kk);
            acc = mma16(a, w, acc); }
        const float bias = bias1[lk * 64 + 16 * nt + fr];
#pragma unroll
        for (int r = 0; r < 4; ++r) { const float xv = acc[r] + bias;
            const float u = 0.7978845608028654f * (xv + 0.044715f * xv * xv * xv);
            const float th = 1.0f - 2.0f * __builtin_amdgcn_rcpf(1.0f + fexp(2.0f * u));
            const float gl = 0.5f * xv * (1.0f + th);
            Hs[(16 * mt + 4 * fq + r) * 72 + 16 * nt + fr] = (bf16)f2bf(gl); }
    }
    __syncthreads();
    {
        const bf16* w2t = W2C + ((size_t)lk * 64 + 16 * nt + fr) * 64 + 8 * fq;
        f32x4 acc = (f32x4){0.f, 0.f, 0.f, 0.f};
#pragma unroll
        for (int kk = 0; kk < 2; ++kk) { const bf16x8 a = *(const LAS bf16x8*)(Hs + (16 * mt + fr) * 72 + 32 * kk + 8 * fq); const bf16x8 w = *(const bf16x8*)(w2t + 32 * kk); acc = mma16(a, w, acc); }
        const int n0 = 32 * rb + 16 * mt + 4 * fq;
        if (kv == 0) { bf16* dstp = KC + (size_t)(b * 2 + g) * 128 * 64;
#pragma unroll
            for (int r = 0; r < 4; ++r) dstp[(n0 + r) * 64 + 16 * nt + fr] = (n0 + r < 127) ? (bf16)f2bf(acc[r]) : (bf16)0;
        } else {
            v2u w; w.x = pk2(acc[0], acc[1]); w.y = pk2(acc[2], (n0 + 3 < 127) ? acc[3] : 0.f);
            *(v2u*)(VC + ((size_t)(b * 2 + g) * 64 + 16 * nt + fr) * 128 + n0) = w; }
    }
    __syncthreads();
}

__device__ __forceinline__ void m1_vt(Frame& F, int unit) {
    bf16* const VT = P_VT;
    const int chunk = unit & 7, g = (unit >> 3) & 1, brm = (unit >> 4) & 1, b = unit >> 5;
    const bf16* const PROJ = P_PROJ_B(b);
    LAS bf16* Ls = (LAS bf16*)F.lds;
    const int colV = C_KV + (((1 + brm) * 2 + 1) * 2 + g) * 64 + 8 * F.wave;
#pragma unroll
    for (int i = 0; i < 4; ++i) { const int r = F.lane + 64 * i;
        const v4u vv = *(const v4u*)(PROJ + ((size_t)b * SEQ + 256 * chunk + r) * NPROJ + colV);
        LAS bf16* vp = Ls + (8 * F.wave) * 264 + r;
        vp[0 * 264] = (bf16)(vv.x & 0xffffu); vp[1 * 264] = (bf16)(vv.x >> 16); vp[2 * 264] = (bf16)(vv.y & 0xffffu); vp[3 * 264] = (bf16)(vv.y >> 16);
        vp[4 * 264] = (bf16)(vv.z & 0xffffu); vp[5 * 264] = (bf16)(vv.z >> 16); vp[6 * 264] = (bf16)(vv.w & 0xffffu); vp[7 * 264] = (bf16)(vv.w >> 16); }
    __syncthreads();
#pragma unroll
    for (int i = 0; i < 4; ++i) { const int idx = F.tid + 512 * i, d = idx >> 5, c = idx & 31;
        *(v4u*)(VT + ((size_t)((b * 2 + brm) * 2 + g) * 64 + d) * SEQ + 256 * chunk + 8 * c) = *(const LAS v4u*)(Ls + d * 264 + 8 * c); }
    __syncthreads();
}

__device__ __forceinline__ void m1_gla_pool(Frame& F, int l, int unit) {
    bf16* const QK = P_QK; const bf16* const W2G = P_W2G; const float* const gla_b = P_gla_b; float* const decay = P_decay; float* const dst = P_dst; const bf16* const WP = P_WP; const float* const pool_s = P_pool_s;
    const int b = unit >> 5, n = unit & 31; const bf16* const PROJ = P_PROJ_B(b); bf16* const MIXED = P_MIXED_B(b); const size_t row0 = (size_t)b * SEQ + 64 * n;
    const int fr = F.lane & 15, fq = F.lane >> 4;
    LAS float* BC = (LAS float*)F.lds;
    LAS bf16* KeT = (LAS bf16*)(F.lds + 49152);
    LAS bf16* VT = (LAS bf16*)(F.lds + 49152 + 27648);
    v4u qreg[3], kreg[3], vreg[6], ureg[5];
#pragma unroll
    for (int i = 0; i < 3; ++i) { const int idx = F.tid + 512 * i, c = idx / 24, col0 = 8 * (idx % 24);
        qreg[i] = *(const v4u*)(PROJ + (row0 + c) * NPROJ + C_GQ + col0); kreg[i] = *(const v4u*)(PROJ + (row0 + c) * NPROJ + C_GK + col0); }
#pragma unroll
    for (int i = 0; i < 6; ++i) { const int idx = F.tid + 512 * i, c = idx / 48, ch = idx % 48; vreg[i] = *(const v4u*)(PROJ + (row0 + c) * NPROJ + C_GV + 8 * ch); }
#pragma unroll
    for (int i = 0; i < 5; ++i) { const int idx = F.tid + 512 * i, r = idx >> 5, ch = idx & 31, sp = 64 * n + r - 15; ureg[i] = (v4u){0u, 0u, 0u, 0u};
        if (idx < 79 * 32 && sp >= 0) ureg[i] = *(const v4u*)(PROJ + ((size_t)b * SEQ + sp) * NPROJ + C_PU + 8 * ch); }
    __builtin_amdgcn_sched_barrier(0);
#pragma unroll
    for (int hb = 0; hb < 2; ++hb) {
    v4u zav[3], zbv[3]; float zbias[3];
#pragma unroll
    for (int i = 0; i < 3; ++i) { const int id = F.wave + NWAVES * (3 * hb + i), mt = id & 3, nt = id >> 2;
        zav[i] = (v4u){0u, 0u, 0u, 0u};
        if (fq < 2) zav[i] = *(const v4u*)(PROJ + (row0 + 16 * mt + fr) * NPROJ + C_GLR + 8 * fq);
        zbv[i] = *(const v4u*)(W2G + ((size_t)l * 192 + 16 * nt + fr) * 32 + 8 * fq);
        zbias[i] = gla_b[l * 192 + 16 * nt + fr]; }
#pragma unroll
    for (int i = 0; i < 3; ++i) { const int id = F.wave + NWAVES * (3 * hb + i);
        const int mt = id & 3, nt = id >> 2;
        const f32x4 z = mma16(as_bf16x8(zav[i]), as_bf16x8(zbv[i]), (f32x4){0.f, 0.f, 0.f, 0.f});
        const float bias = zbias[i];
#pragma unroll
        for (int r = 0; r < 4; ++r) { const float zz = z[r] + bias;
            const float ls = fminf(zz, 0.f) - __logf(1.0f + fexp(-fabsf(zz)));
            BC[(16 * mt + 4 * fq + r) * 192 + 16 * nt + fr] = ls * (1.0f / 16.0f); }
    }
    }
#pragma unroll
    for (int i = 0; i < 6; ++i) { const int idx = F.tid + 512 * i, c = idx / 48, ch = idx % 48; const v4u vv = vreg[i];
        LAS bf16* vp = VT + (8 * ch) * 72 + c;
        vp[0 * 72] = (bf16)(vv.x & 0xffffu); vp[1 * 72] = (bf16)(vv.x >> 16); vp[2 * 72] = (bf16)(vv.y & 0xffffu); vp[3 * 72] = (bf16)(vv.y >> 16);
        vp[4 * 72] = (bf16)(vv.z & 0xffffu); vp[5 * 72] = (bf16)(vv.z >> 16); vp[6 * 72] = (bf16)(vv.w & 0xffffu); vp[7 * 72] = (bf16)(vv.w >> 16); }
    __syncthreads();
    if (F.tid < 192) { float run = 0.f;
#pragma unroll 8
        for (int c = 0; c < 64; ++c) { run += BC[c * 192 + F.tid]; BC[c * 192 + F.tid] = run; } }
    __syncthreads();
#pragma unroll
    for (int i = 0; i < 3; ++i) { const int idx = F.tid + 512 * i, c = idx / 24, col0 = 8 * (idx % 24);
        const v4u qv = qreg[i], kvv = kreg[i];
        float bc[8], bl[8], qf[8], kf[8];
#pragma unroll
        for (int e = 0; e < 8; ++e) { bc[e] = BC[c * 192 + col0 + e]; bl[e] = BC[63 * 192 + col0 + e]; }
        qf[0] = bflo(qv.x); qf[1] = bfhi(qv.x); qf[2] = bflo(qv.y); qf[3] = bfhi(qv.y); qf[4] = bflo(qv.z); qf[5] = bfhi(qv.z); qf[6] = bflo(qv.w); qf[7] = bfhi(qv.w);
        kf[0] = bflo(kvv.x); kf[1] = bfhi(kvv.x); kf[2] = bflo(kvv.y); kf[3] = bfhi(kvv.y); kf[4] = bflo(kvv.z); kf[5] = bfhi(kvv.z); kf[6] = bflo(kvv.w); kf[7] = bfhi(kvv.w);
        float qd[8], ki[8];
#pragma unroll
        for (int e = 0; e < 8; ++e) { qd[e] = qf[e] * 0.17677669529663687f * fexp(bc[e]); ki[e] = kf[e] * fexp(-bc[e]);
            KeT[(col0 + e) * 72 + c] = (bf16)f2bf(kf[e] * fexp(bl[e] - bc[e])); }
        v4u qo, ko; qo.x = pk2(qd[0], qd[1]); qo.y = pk2(qd[2], qd[3]); qo.z = pk2(qd[4], qd[5]); qo.w = pk2(qd[6], qd[7]);
        ko.x = pk2(ki[0], ki[1]); ko.y = pk2(ki[2], ki[3]); ko.z = pk2(ki[4], ki[5]); ko.w = pk2(ki[6], ki[7]);
        *(v4u*)(QK + (row0 + c) * 384 + col0) = qo; *(v4u*)(QK + (row0 + c) * 384 + 192 + col0) = ko;
    }
    if (F.tid < 192) { const int h = F.tid >> 5, dk = F.tid & 31; decay[(((size_t)b * 6 + h) * 32 + n) * 32 + dk] = fexp(BC[63 * 192 + F.tid]); }
    __syncthreads();
    for (int id = F.wave; id < 48; id += NWAVES) {
        const int h = id >> 3, mt = (id >> 2) & 1, nt = id & 3;
        f32x4 acc = (f32x4){0.f, 0.f, 0.f, 0.f};
#pragma unroll
        for (int kk = 0; kk < 2; ++kk) { const bf16x8 a = *(const LAS bf16x8*)(KeT + (h * 32 + 16 * mt + fr) * 72 + 32 * kk + 8 * fq);
            const bf16x8 w = *(const LAS bf16x8*)(VT + (h * 64 + 16 * nt + fr) * 72 + 32 * kk + 8 * fq); acc = mma16(w, a, acc); }
        *(f32x4*)(dst + ((((size_t)b * 6 + h) * 32 + n) * 32 + 16 * mt + fr) * 64 + 16 * nt + 4 * fq) = acc;
    }
    __syncthreads();
    LAS bf16* Us = (LAS bf16*)F.lds;
    LAS bf16* Ps = (LAS bf16*)(F.lds + 45056);
#pragma unroll
    for (int i = 0; i < 5; ++i) { const int idx = F.tid + 512 * i, r = idx >> 5, ch = idx & 31; if (idx < 79 * 32) *(LAS v4u*)(Us + r * 264 + 8 * ch) = ureg[i]; }
    __syncthreads();
    {
        const int c = F.tid & 255, th = F.tid >> 8, w = 2 << (c >> 6), t0 = 32 * th;
        float s = 0.f;
        for (int tau = 0; tau < w; ++tau) s += bf2f(Us[(15 + t0 - tau) * 264 + c]);
#pragma unroll 4
        for (int t = t0; t < t0 + 32; ++t) {
            const float ut = bf2f(Us[(15 + t) * 264 + c]);
            if (t > t0) s += ut - bf2f(Us[(15 + t - w) * 264 + c]);
            const int sp = 64 * n + t; const int cnt = (sp + 1 < w) ? sp + 1 : w;
            Ps[t * 264 + c] = (bf16)f2bf(s * __builtin_amdgcn_rcpf((float)cnt) - ut);
        }
    }
    __syncthreads();
    bf16x8 pw[8][2]; f32x4 psc[8];
#pragma unroll
    for (int i = 0; i < 8; ++i) { const int id = F.wave + NWAVES * i, g = id >> 4, nt = id & 3;
        const bf16* wp = WP + ((size_t)(l * 4 + g) * 64 + 16 * nt + fr) * 64 + 8 * fq;
        pw[i][0] = *(const bf16x8*)(wp); pw[i][1] = *(const bf16x8*)(wp + 32); psc[i] = *(const f32x4*)(pool_s + l * 256 + 64 * g + 16 * nt + 4 * fq); }
#pragma unroll
    for (int i = 0; i < 8; ++i) { const int id = F.wave + NWAVES * i;
        const int g = id >> 4, mt = (id >> 2) & 3, nt = id & 3;
        f32x4 acc = (f32x4){0.f, 0.f, 0.f, 0.f};
#pragma unroll
        for (int kk = 0; kk < 2; ++kk) { const bf16x8 a = *(const LAS bf16x8*)(Ps + (16 * mt + fr) * 264 + 64 * g + 32 * kk + 8 * fq); acc = mma16(pw[i][kk], a, acc); }
        acc = acc * psc[i];
        v2u ow; ow.x = pk2(acc[0], acc[1]); ow.y = pk2(acc[2], acc[3]);
        *(v2u*)(MIXED + (row0 + 16 * mt + fr) * D + 768 + 64 * g + 16 * nt + 4 * fq) = ow;
    }
    __syncthreads();
}

__device__ __forceinline__ void m2_gla(Frame& F, int l, int unit) {
    FRAME_REFRESH(F);
    const bf16* const QK = P_QK; const float* const decay = P_decay; const float* const dst = P_dst; const float* const gla_ng = P_gla_ng;
    const int cgrp = unit & 7, hp = (unit >> 3) % 3, b = unit / 24; const bf16* const PROJ = P_PROJ_B(b); bf16* const MIXED = P_MIXED_B(b);
    const int half = F.wave >> 2, wq = F.wave & 3, h = 2 * hp + half, lh = wq * 64 + F.lane, fr = F.lane & 15, fq = F.lane >> 4;
    LAS bf16* base = (LAS bf16*)(F.lds + half * 52224);
    LAS bf16* Qs = base;
    LAS bf16* Ks = base + 2560;
    LAS bf16* Vs = base + 5120;
    LAS bf16* As = base + 9728;
    LAS bf16* St = base + 14336;
    LAS bf16* Gs = base + 16896;
    LAS bf16* Os = base + 21504;
    const int dk = lh >> 3, dv0 = (lh & 7) * 8;
    const size_t bh = (size_t)b * 6 + h;
    f32x4 S0 = (f32x4){0.f, 0.f, 0.f, 0.f}, S1 = S0;
    for (int j4 = 0; j4 < cgrp; ++j4) {
        float dc[4]; f32x4 e0[4], e1[4];
#pragma unroll
        for (int u = 0; u < 4; ++u) { const int j = 4 * j4 + u; dc[u] = decay[(bh * 32 + j) * 32 + dk]; const float* dp = dst + ((bh * 32 + j) * 32 + dk) * 64 + dv0; e0[u] = *(const f32x4*)dp; e1[u] = *(const f32x4*)(dp + 4); }
#pragma unroll
        for (int u = 0; u < 4; ++u) { S0 = S0 * dc[u] + e0[u]; S1 = S1 * dc[u] + e1[u]; }
    }
    float ngl[4];
#pragma unroll
    for (int nt = 0; nt < 4; ++nt) ngl[nt] = gla_ng[l * 384 + h * 64 + 16 * nt + fr];
    const int qr = lh >> 2, qc = lh & 3;
    v4u qv, kvv, vv[2], gv[2]; f32x4 d0, d1; float dcn;
#define GLA_FETCH(nn) do { const size_t rw_ = (size_t)b * SEQ + 64 * (nn); \
        qv = *(const v4u*)(QK + (rw_ + qr) * 384 + h * 32 + 8 * qc); kvv = *(const v4u*)(QK + (rw_ + qr) * 384 + 192 + h * 32 + 8 * qc); \
        _Pragma("unroll") for (int i_ = 0; i_ < 2; ++i_) { const int ix_ = lh + 256 * i_, r_ = ix_ >> 3, c_ = ix_ & 7; \
            vv[i_] = *(const v4u*)(PROJ + (rw_ + r_) * NPROJ + C_GV + h * 64 + 8 * c_); gv[i_] = *(const v4u*)(PROJ + (rw_ + r_) * NPROJ + C_OG + h * 64 + 8 * c_); } \
        dcn = decay[(bh * 32 + (nn)) * 32 + dk]; { const float* dp_ = dst + ((bh * 32 + (nn)) * 32 + dk) * 64 + dv0; d0 = *(const f32x4*)dp_; d1 = *(const f32x4*)(dp_ + 4); } } while (0)
    GLA_FETCH(4 * cgrp);
    for (int cc = 0; cc < 4; ++cc) {
        const int n = 4 * cgrp + cc; const size_t rowc = (size_t)b * SEQ + 64 * n;
#pragma unroll
        for (int e = 0; e < 4; ++e) { St[(dv0 + e) * 40 + dk] = (bf16)f2bf(S0[e]); St[(dv0 + 4 + e) * 40 + dk] = (bf16)f2bf(S1[e]); }
        *(LAS v4u*)(Qs + qr * 40 + 8 * qc) = qv; *(LAS v4u*)(Ks + qr * 40 + 8 * qc) = kvv;
#pragma unroll
        for (int i = 0; i < 2; ++i) { const int idx = lh + 256 * i, r = idx >> 3, ch = idx & 7;
            *(LAS v4u*)(Gs + r * 72 + 8 * ch) = gv[i];
            LAS bf16* vp = Vs + (8 * ch) * 72 + r; const v4u w = vv[i];
            vp[0 * 72] = (bf16)(w.x & 0xffffu); vp[1 * 72] = (bf16)(w.x >> 16); vp[2 * 72] = (bf16)(w.y & 0xffffu); vp[3 * 72] = (bf16)(w.y >> 16);
            vp[4 * 72] = (bf16)(w.z & 0xffffu); vp[5 * 72] = (bf16)(w.z >> 16); vp[6 * 72] = (bf16)(w.w & 0xffffu); vp[7 * 72] = (bf16)(w.w >> 16); }
        S0 = S0 * dcn + d0; S1 = S1 * dcn + d1;
        __syncthreads();
        if (cc < 3) GLA_FETCH(n + 1);
        const bf16x8 qa = *(const LAS bf16x8*)(Qs + (16 * wq + fr) * 40 + 8 * fq);
#pragma unroll
        for (int jt = 0; jt < 4; ++jt) {
            f32x4 a = (f32x4){0.f, 0.f, 0.f, 0.f};
            if (jt <= wq) { const bf16x8 kb = *(const LAS bf16x8*)(Ks + (16 * jt + fr) * 40 + 8 * fq); a = mma16(qa, kb, a); }
#pragma unroll
            for (int r = 0; r < 4; ++r) { const int i = 16 * wq + 4 * fq + r, j = 16 * jt + fr; As[i * 72 + j] = (bf16)f2bf((j <= i) ? a[r] : 0.f); }
        }
        LDS_WAIT(); asm volatile("" ::: "memory");
        f32x4 o[4];
        const bf16x8 a0 = *(const LAS bf16x8*)(As + (16 * wq + fr) * 72 + 8 * fq), a1 = *(const LAS bf16x8*)(As + (16 * wq + fr) * 72 + 32 + 8 * fq);
#pragma unroll
        for (int nt = 0; nt < 4; ++nt) {
            f32x4 acc = (f32x4){0.f, 0.f, 0.f, 0.f};
            acc = mma16(a0, *(const LAS bf16x8*)(Vs + (16 * nt + fr) * 72 + 8 * fq), acc);
            acc = mma16(a1, *(const LAS bf16x8*)(Vs + (16 * nt + fr) * 72 + 32 + 8 * fq), acc);
            acc = mma16(qa, *(const LAS bf16x8*)(St + (16 * nt + fr) * 40 + 8 * fq), acc);
            o[nt] = acc;
        }
#pragma unroll
        for (int r = 0; r < 4; ++r) {
            float ss = o[0][r] * o[0][r] + o[1][r] * o[1][r] + o[2][r] * o[2][r] + o[3][r] * o[3][r];
            ss += __builtin_bit_cast(float, __builtin_amdgcn_update_dpp(0, __builtin_bit_cast(int, ss), 0xB1, 0xF, 0xF, true));
            ss += __builtin_bit_cast(float, __builtin_amdgcn_update_dpp(0, __builtin_bit_cast(int, ss), 0x4E, 0xF, 0xF, true));
            ss += __builtin_bit_cast(float, __builtin_amdgcn_update_dpp(0, __builtin_bit_cast(int, ss), 0x141, 0xF, 0xF, true));
            ss += __builtin_bit_cast(float, __builtin_amdgcn_update_dpp(0, __builtin_bit_cast(int, ss), 0x140, 0xF, 0xF, true));
            const float rstd = __builtin_amdgcn_rsqf(ss * (1.0f / 64.0f) + RMS_EPS);
            const int i = 16 * wq + 4 * fq + r;
#pragma unroll
            for (int nt = 0; nt < 4; ++nt) { const int dv = 16 * nt + fr; const float og = bf2f(Gs[i * 72 + dv]);
                Os[i * 72 + dv] = (bf16)f2bf(o[nt][r] * rstd * ngl[nt] * (og * sigmoidf_(og))); }
        }
        LDS_WAIT(); asm volatile("" ::: "memory");
#pragma unroll
        for (int i2 = 0; i2 < 2; ++i2) { const int rr = 16 * wq + 8 * i2 + (F.lane >> 3), ch = F.lane & 7;
            *(v4u*)(MIXED + (rowc + rr) * D + 384 + h * 64 + 8 * ch) = *(const LAS v4u*)(Os + rr * 72 + 8 * ch); }
        __syncthreads();
    }
#undef GLA_FETCH
}

__device__ __forceinline__ int kperm(int rho) { return (rho & ~12) | ((rho & 4) << 1) | ((rho & 8) >> 1); }
__device__ __forceinline__ bf16x8 pack8(const f32x16& p, int s) {
    v4u w; w.x = pk2(p[8 * s + 0], p[8 * s + 1]); w.y = pk2(p[8 * s + 2], p[8 * s + 3]); w.z = pk2(p[8 * s + 4], p[8 * s + 5]); w.w = pk2(p[8 * s + 6], p[8 * s + 7]);
    return as_bf16x8(w);
}
constexpr float NEG_INF = -__builtin_inff();

template <int BR>
__device__ __forceinline__ void attn_tile(const LAS bf16* Kt, const LAS bf16* Vt, const bf16x8 (&qf)[4], f32x16 (&o)[2], float& mref, float& rmax, float& lsum, int d, int kind, int q, int hi, const f32x16& zero16) {
    f32x16 s[2];
    const int prow = kperm(q);
    {
        bf16x8 kf[2][4];
#pragma unroll
        for (int st = 0; st < 2; ++st)
#pragma unroll
            for (int ds = 0; ds < 4; ++ds) kf[st][ds] = *(const LAS bf16x8*)(Kt + (32 * st + prow) * 72 + 16 * ds + 8 * hi);
        __builtin_amdgcn_sched_barrier(0);
#pragma unroll
        for (int st = 0; st < 2; ++st) {
            s[st] = mma32(kf[st][0], qf[0], zero16);
#pragma unroll
            for (int ds = 1; ds < 4; ++ds) s[st] = mma32(kf[st][ds], qf[ds], s[st]);
        }
    }
    bf16x8 vf0[4];
#pragma unroll
    for (int k = 0; k < 4; ++k) vf0[k] = *(const LAS bf16x8*)(Vt + q * 72 + 16 * k + 8 * hi);
    __builtin_amdgcn_sched_barrier(0);
    if (__any(mref != 0.f)) {
#pragma unroll
        for (int st = 0; st < 2; ++st)
#pragma unroll
            for (int r = 0; r < 16; ++r) asm volatile("v_sub_f32 %0, %0, %1" : "+v"(s[st][r]) : "v"(mref));
    }
    if (kind == 1) {
        const float ninf = NEG_INF;
        if (BR == 0) {
#pragma unroll
            for (int st = 0; st < 2; ++st)
#pragma unroll
                for (int r = 0; r < 16; ++r) asm volatile("v_cmp_gt_i32 vcc, %1, %2\n\ts_nop 1\n\tv_cndmask_b32 %0, %0, %3, vcc" : "+v"(s[st][r]) : "n"(32 * st + 16 * (r >> 3) + (r & 7)), "v"(d), "v"(ninf) : "vcc");
        } else {
#pragma unroll
            for (int st = 0; st < 2; ++st)
#pragma unroll
                for (int r = 0; r < 16; ++r) { unsigned t_; asm volatile("v_subrev_u32 %1, %2, %3\n\tv_cmp_lt_u32 vcc, 511, %1\n\ts_nop 1\n\tv_cndmask_b32 %0, %0, %4, vcc" : "+v"(s[st][r]), "=&v"(t_) : "n"(32 * st + 16 * (r >> 3) + (r & 7)), "v"(d), "v"(ninf) : "vcc"); }
        }
    }
    const bool rowok = (BR == 1) || kind != 2 || d >= 0;
    float mx = NEG_INF;
#pragma unroll
    for (int st = 0; st < 2; ++st)
#pragma unroll
        for (int r = 0; r < 16; ++r) mx = fmaxf(mx, s[st][r]);
    if (BR == 0) mx = rowok ? mx : NEG_INF;
    mx = fmaxf(mx, shx(mx, 32, q + 32 * hi));
    rmax = fmaxf(rmax, mx);
    if (__any(rmax > 8.0f || (rmax < -100.0f && rmax != NEG_INF))) {
        const float delta = (rmax == NEG_INF) ? 0.f : rmax, alpha = ex2(-delta);
        mref += delta; rmax -= delta; lsum *= alpha;
#pragma unroll
        for (int st = 0; st < 2; ++st)
#pragma unroll
            for (int r = 0; r < 16; ++r) { asm volatile("v_mul_f32 %0, %0, %1" : "+v"(o[st][r]) : "v"(alpha)); asm volatile("v_sub_f32 %0, %0, %1" : "+v"(s[st][r]) : "v"(delta)); }
    }
    float ps = 0.f;
#pragma unroll
    for (int st = 0; st < 2; ++st)
#pragma unroll
        for (int r = 0; r < 16; ++r) { const float p = ex2(s[st][r]); s[st][r] = p; ps += p; }
    if (BR == 0) ps = rowok ? ps : 0.f;
    lsum += ps;
    bf16x8 pf[4];
#pragma unroll
    for (int k = 0; k < 4; ++k) { pf[k] = pack8(s[k >> 1], k & 1);
        if (BR == 0) { const unsigned m = rowok ? ~0u : 0u; v4u w = __builtin_bit_cast(v4u, pf[k]); w.x &= m; w.y &= m; w.z &= m; w.w &= m; pf[k] = as_bf16x8(w); } }
    bf16x8 vf1[4];
#pragma unroll
    for (int k = 0; k < 4; ++k) vf1[k] = *(const LAS bf16x8*)(Vt + (32 + q) * 72 + 16 * k + 8 * hi);
#pragma unroll
    for (int k = 0; k < 4; ++k) o[0] = mma32(vf0[k], pf[k], o[0]);
#pragma unroll
    for (int k = 0; k < 4; ++k) o[1] = mma32(vf1[k], pf[k], o[1]);
}
__device__ __forceinline__ void cmp_scores(const LAS bf16* KCs, const bf16x8 (&qf)[4], f32x16 (&s)[4], float& mx, int dc, int prow, int hi, int nst, int nfull) {
    mx = NEG_INF;
#pragma unroll
    for (int st = 0; st < 4; ++st) {
        if (st < nst) {
#pragma unroll
            for (int e = 0; e < 16; ++e) s[st][e] = 0.f;
            bf16x8 kf[4];
#pragma unroll
            for (int ds = 0; ds < 4; ++ds) kf[ds] = *(const LAS bf16x8*)(KCs + (32 * st + prow) * 72 + 16 * ds + 8 * hi);
#pragma unroll
            for (int ds = 0; ds < 4; ++ds) s[st] = mma32(kf[ds], qf[ds], s[st]);
            if (st < nfull) {
#pragma unroll
                for (int r = 0; r < 16; ++r) mx = fmaxf(mx, s[st][r]);
            } else {
#pragma unroll
                for (int r = 0; r < 16; ++r) { const int c16 = 16 * (32 * st + 16 * (r >> 3) + (r & 7)); const float v = (dc >= c16) ? s[st][r] : NEG_INF; s[st][r] = v; mx = fmaxf(mx, v); }
            }
        }
    }
    mx = fmaxf(mx, shx(mx, 32, (prow & ~12) | ((prow & 4) << 1) | ((prow & 8) >> 1) | (hi << 5)));
}
__device__ __forceinline__ void sort16(int (&a)[16]) {
#pragma unroll
    for (int k = 2; k <= 16; k <<= 1)
#pragma unroll
        for (int j = k >> 1; j > 0; j >>= 1)
#pragma unroll
            for (int i = 0; i < 16; ++i) { const int l = i ^ j;
                if (l > i) { const int x = a[i], y = a[l], lo = x < y ? x : y, hg = x < y ? y : x; const bool asc = (i & k) == 0; a[i] = asc ? lo : hg; a[l] = asc ? hg : lo; } }
}

__device__ __forceinline__ void m2_nsa(Frame& F, int uid) {
    FRAME_REFRESH(F);
    const bf16* const KC = P_KC; const bf16* const VCT = P_VC; const bf16* const VT = P_VT;
    const int h = uid % 3, bgp = uid / 3, pt = bgp >> 5, bg = bgp & 31, b = bg >> 1, g = bg & 1; const bf16* const PROJ = P_PROJ_B(b); bf16* const MIXED = P_MIXED_B(b);
    const int p0 = 256 * pt, pw = p0 + 32 * F.wave, q = F.lane & 31, hi = F.lane >> 5, pos = pw + q, cur = pw >> 6;
    const size_t rowq = (size_t)b * SEQ + pos;
    LAS bf16* KCs = (LAS bf16*)F.lds;
    LAS bf16* VCt = (LAS bf16*)(F.lds + 18432);
    LAS bf16* Ks0 = (LAS bf16*)(F.lds + 35840);
    LAS bf16* Vs0 = (LAS bf16*)(F.lds + 54272);
    LAS bf16* Kw0 = (LAS bf16*)(F.lds + 72704);
    LAS bf16* Vw0 = (LAS bf16*)(F.lds + 91136);
#pragma unroll
    for (int i = 0; i < 2; ++i) { const int idx = F.tid + 512 * i;
        { const int key = idx >> 3, ch = idx & 7; *(LAS v4u*)(KCs + key * 72 + 8 * ch) = *(const v4u*)(KC + ((size_t)bg * 128 + key) * 64 + 8 * ch); }
        { const int d = idx >> 4, ch = idx & 15; *(LAS v4u*)(VCt + d * 136 + 8 * ch) = *(const v4u*)(VCT + ((size_t)bg * 64 + d) * 128 + 8 * ch); } }
    __syncthreads();
    const int prow = kperm(q);
    const int pws = __builtin_amdgcn_readfirstlane(pw);
    const int nst = (pws >> 9) + 1, nfull = (pws >= 527) ? ((pws - 527) >> 9) + 1 : 0;
    unsigned selmask;
    {
        float loc[8][3];
#pragma unroll
        for (int G = 0; G < 8; ++G) { loc[G][0] = 0.f; loc[G][1] = 0.f; loc[G][2] = 0.f; }
#pragma unroll 1
        for (int hh = 0; hh < 3; ++hh) {
            bf16x8 qf[4];
#pragma unroll
            for (int ds = 0; ds < 4; ++ds) qf[ds] = *(const bf16x8*)(PROJ + rowq * NPROJ + C_Q + (g * 3 + hh) * 64 + 16 * ds + 8 * hi);
            f32x16 s[4]; float mx;
            { int dc = pos - 128 * hi - 31; asm volatile("" : "+v"(dc)); cmp_scores(KCs, qf, s, mx, dc, prow, hi, nst, nfull); }
            const float msafe = (mx == NEG_INF) ? 0.f : mx;
            float ps = 0.f;
#pragma unroll
            for (int st = 0; st < 4; ++st) if (st < nst) {
#pragma unroll
                for (int r = 0; r < 16; ++r) { const float p = ex2(s[st][r] - msafe); s[st][r] = p; ps += p; } }
            ps += shx(ps, 32, F.lane);
            const float inv = 1.0f / fmaxf(ps, 1e-30f);
#pragma unroll
            for (int st = 0; st < 4; ++st) if (st < nst)
#pragma unroll
                for (int u = 0; u < 2; ++u) { const int G = 2 * st + u; const int r0 = 8 * u;
                    loc[G][0] += (s[st][r0 + 0] + s[st][r0 + 1] + s[st][r0 + 2] + 0.5f * s[st][r0 + 3]) * inv;
                    loc[G][1] += (0.5f * s[st][r0 + 3] + s[st][r0 + 4] + s[st][r0 + 5] + s[st][r0 + 6] + 0.5f * s[st][r0 + 7]) * inv;
                    loc[G][2] += (0.5f * s[st][r0 + 7]) * inv; }
        }
        float imp[32];
#pragma unroll
        for (int G = 0; G < 8; ++G) {
            const float o0 = shx(loc[G][0], 32, F.lane), o1 = shx(loc[G][1], 32, F.lane), o2 = shx(loc[G][2], 32, F.lane);
            const float a0 = hi ? o0 : loc[G][0], a1 = hi ? o1 : loc[G][1], a2 = hi ? o2 : loc[G][2];
            const float b0 = hi ? loc[G][0] : o0, b1 = hi ? loc[G][1] : o1, b2 = hi ? loc[G][2] : o2;
            if (G == 0) imp[0] = a0; else imp[4 * G] += a0;
            imp[4 * G + 1] = a1; imp[4 * G + 2] = a2 + b0; imp[4 * G + 3] = b1;
            if (G < 7) imp[4 * G + 4] = b2;
        }
        const int curq = pos >> 6;
#pragma unroll
        for (int j = 0; j < 32; ++j) { float v = imp[j]; if (j == 0 || j == curq || j == curq - 1) v = 1.0e4f; if (j > curq) v = -1.0e4f; imp[j] = v; }
        int key[32];
#pragma unroll
        for (int j = 0; j < 32; ++j) { const unsigned u = __builtin_bit_cast(unsigned, imp[j]); const unsigned ord = (u & 0x80000000u) ? ~u : (u | 0x80000000u);
            key[j] = (int)(((ord >> 1) & ~31u) | (unsigned)(31 - j)); }
        int ka[16], kb[16];
#pragma unroll
        for (int j = 0; j < 16; ++j) { ka[j] = key[j]; kb[j] = key[16 + j]; }
        sort16(ka); sort16(kb);
        int thr = 0x7fffffff;
#pragma unroll
        for (int j = 0; j < 16; ++j) { const int mj = ka[j] > kb[15 - j] ? ka[j] : kb[15 - j]; thr = mj < thr ? mj : thr; }
        unsigned m16 = 0u;
#pragma unroll
        for (int jj = 0; jj < 16; ++jj) { const int kj = hi ? key[16 + jj] : key[jj]; m16 |= (((unsigned)(kj - thr) >> 31) ^ 1u) << jj; }
        selmask = hi ? (m16 << 16) : m16; selmask |= shxu(selmask, 32, F.lane);
    }
    const int kkey = F.tid >> 3, kch = F.tid & 7;
    const int t_hi = (p0 + 255) >> 6;
    const int w_lo = (p0 >= 511) ? ((p0 - 511) >> 6) : 0;
    bf16x8 qf[4];
#pragma unroll
    for (int ds = 0; ds < 4; ++ds) qf[ds] = *(const bf16x8*)(PROJ + rowq * NPROJ + C_Q + (g * 3 + h) * 64 + 16 * ds + 8 * hi);
    const bf16* gp = PROJ + rowq * NPROJ + C_GATE + (g * 3 + h) * 3;
    const float g0 = sigmoidf_(bf2f(gp[0])), g1 = sigmoidf_(bf2f(gp[1])), g2 = sigmoidf_(bf2f(gp[2]));
    f32x16 accO[2];
    f32x16 zero16;
#pragma unroll
    for (int e = 0; e < 16; ++e) zero16[e] = 0.f;
    asm volatile("" : "+v"(zero16));
    {
        const bf16* gKs = PROJ + ((size_t)b * SEQ + kkey) * NPROJ + C_KV + ((1 * 2 + 0) * 2 + g) * 64 + 8 * kch;
        const bf16* gKw = PROJ + ((size_t)b * SEQ + kkey) * NPROJ + C_KV + ((2 * 2 + 0) * 2 + g) * 64 + 8 * kch;
        const bf16* gVs = VT + ((size_t)((b * 2 + 0) * 2 + g) * 64 + kkey) * SEQ + 8 * kch;
        const bf16* gVw = VT + ((size_t)((b * 2 + 1) * 2 + g) * 64 + kkey) * SEQ + 8 * kch;
        const int lofs = kkey * 72 + 8 * kch;
        f32x16 os[2], ow[2]; float ms = 0.f, rs_ = NEG_INF, ls = 0.f, mw = 0.f, rw_ = NEG_INF, lw = 0.f;
#pragma unroll
        for (int dt = 0; dt < 2; ++dt)
#pragma unroll
            for (int e = 0; e < 16; ++e) { os[dt][e] = 0.f; ow[dt][e] = 0.f; }
        v4u ksr, vsr, kwr = (v4u){0u, 0u, 0u, 0u}, vwr = (v4u){0u, 0u, 0u, 0u};
        ksr = *(const v4u*)gKs; vsr = *(const v4u*)gVs;
        if (w_lo == 0) { kwr = *(const v4u*)gKw; vwr = *(const v4u*)gVw; }
        *(LAS v4u*)(Ks0 + lofs) = ksr; *(LAS v4u*)(Vs0 + lofs) = vsr; *(LAS v4u*)(Kw0 + lofs) = kwr; *(LAS v4u*)(Vw0 + lofs) = vwr;
        __syncthreads();
#pragma unroll 1
        for (int jt = 0; jt <= t_hi; ++jt) {
            const int nb = jt & 1;
            if (jt < t_hi) { ksr = *(const v4u*)(gKs + (size_t)(64 * (jt + 1)) * NPROJ); vsr = *(const v4u*)(gVs + 64 * (jt + 1));
                if (jt + 1 >= w_lo) { kwr = *(const v4u*)(gKw + (size_t)(64 * (jt + 1)) * NPROJ); vwr = *(const v4u*)(gVw + 64 * (jt + 1)); } }
            int dd = pos - 64 * jt - 8 * hi;
            {
                const bool sel = (selmask >> jt) & 1u;
                if (jt <= cur && __any(sel)) {
                    const int kind = (jt < cur) ? (__all(sel) ? 0 : 2) : 1;
                    int ds_ = (jt < cur) ? (sel ? 0 : -1) : (sel ? dd : -1); asm volatile("" : "+v"(ds_));
                    attn_tile<0>(Ks0 + nb * 4608, Vs0 + nb * 4608, qf, os, ms, rs_, ls, ds_, kind, q, hi, zero16);
                }
            }
            if (64 * jt + 63 + 511 >= pw && 64 * jt <= pw + 31) {
                const int kind = (64 * jt + 63 <= pw && 64 * jt + 511 >= pw + 31) ? 0 : 1;
                asm volatile("" : "+v"(dd));
                attn_tile<1>(Kw0 + nb * 4608, Vw0 + nb * 4608, qf, ow, mw, rw_, lw, dd, kind, q, hi, zero16);
            }
            if (jt < t_hi) { const int o2 = (nb ^ 1) * 4608 + lofs; *(LAS v4u*)(Ks0 + o2) = ksr; *(LAS v4u*)(Vs0 + o2) = vsr; if (jt + 1 >= w_lo) { *(LAS v4u*)(Kw0 + o2) = kwr; *(LAS v4u*)(Vw0 + o2) = vwr; } }
            __syncthreads();
        }
        ls += shx(ls, 32, F.lane); lw += shx(lw, 32, F.lane);
        const float s1 = g1 / fmaxf(ls, 1e-30f), s2 = g2 / fmaxf(lw, 1e-30f);
        accO[0] = os[0] * s1 + ow[0] * s2; accO[1] = os[1] * s1 + ow[1] * s2;
    }
    {
        f32x16 s[4]; float mx;
        { int dc = pos - 128 * hi - 31; asm volatile("" : "+v"(dc)); cmp_scores(KCs, qf, s, mx, dc, prow, hi, nst, nfull); }
        const float msafe = (mx == NEG_INF) ? 0.f : mx;
        float ps = 0.f;
#pragma unroll
        for (int st = 0; st < 4; ++st) if (st < nst) {
#pragma unroll
            for (int r = 0; r < 16; ++r) { const float p = ex2(s[st][r] - msafe); s[st][r] = p; ps += p; } }
        ps += shx(ps, 32, F.lane);
        const float sc = g0 / fmaxf(ps, 1e-30f);
#pragma unroll
        for (int dt = 0; dt < 2; ++dt) {
            f32x16 o;
#pragma unroll
            for (int e = 0; e < 16; ++e) o[e] = 0.f;
            bf16x8 vf[8];
#pragma unroll
            for (int k = 0; k < 8; ++k) vf[k] = *(const LAS bf16x8*)(VCt + (32 * dt + q) * 136 + 16 * k + 8 * hi);
#pragma unroll
            for (int k = 0; k < 8; ++k) if ((k >> 1) < nst) o = mma32(vf[k], pack8(s[k >> 1], k & 1), o);
            accO[dt] = accO[dt] + o * sc;
        }
    }
    bf16* op = MIXED + rowq * D + (g * 3 + h) * 64 + 4 * hi;
#pragma unroll
    for (int dt = 0; dt < 2; ++dt)
#pragma unroll
        for (int rg = 0; rg < 4; ++rg) { v2u w; w.x = pk2(accO[dt][4 * rg + 0], accO[dt][4 * rg + 1]); w.y = pk2(accO[dt][4 * rg + 2], accO[dt][4 * rg + 3]); *(v2u*)(op + 32 * dt + 8 * rg) = w; }
    __syncthreads();
}
__device__ const unsigned short M2_OFFS[257] = {0,4,8,12,16,20,24,28,32,36,40,44,48,52,56,60,64,68,72,76,80,84,88,92,96,100,104,108,112,116,120,124,128,132,136,140,144,148,152,156,160,164,168,172,176,180,184,188,192,196,200,204,208,212,216,220,224,228,232,236,240,244,248,252,256,260,264,268,272,276,280,284,288,292,296,300,304,308,312,316,320,324,328,332,336,340,344,348,352,356,360,364,368,372,376,380,384,389,394,399,404,409,414,419,424,429,434,439,444,449,454,459,464,469,474,479,484,489,494,499,504,509,514,519,524,529,534,539,544,549,554,559,564,569,574,579,584,589,594,599,604,609,614,619,624,629,634,639,644,649,654,659,664,669,674,679,684,689,694,699,704,708,712,716,720,724,728,732,736,740,744,748,752,756,760,764,768,772,776,780,784,788,792,796,800,804,808,812,816,820,824,828,832,837,842,847,852,857,862,867,872,877,882,887,892,897,902,907,912,917,922,927,932,937,942,947,952,957,962,967,972,977,982,987,992,997,1002,1007,1012,1017,1022,1027,1032,1037,1042,1047,1052,1057,1062,1067,1072,1077,1082,1087,1092,1097,1102,1107,1112,1117,1122,1127,1132,1137,1142,1147,1152};
__device__ const unsigned short M2_LIST[1152] = {672,496,774,1027,673,497,782,1035,674,498,790,1043,675,499,798,1051,676,500,806,1059,677,501,814,1067,678,502,822,1075,679,503,830,1083,680,504,838,1091,681,505,846,1099,682,506,854,1107,683,507,862,1115,684,508,870,1123,685,509,878,1131,686,510,886,1139,687,511,894,1147,688,512,775,770,689,513,783,778,690,514,791,786,691,515,799,794,692,516,807,802,693,517,815,810,694,518,823,818,695,519,831,826,696,520,839,834,697,521,847,842,698,522,855,850,699,523,863,858,700,524,871,866,701,525,879,874,702,526,887,882,703,527,895,890,704,528,160,896,705,529,161,904,706,530,162,912,707,531,163,920,708,532,164,928,709,533,165,936,710,534,166,944,711,535,167,952,712,536,168,960,713,537,169,968,714,538,170,976,715,539,171,984,716,540,172,992,717,541,173,1000,718,542,174,1008,719,543,175,1016,720,480,176,1024,721,481,177,1032,722,482,178,1040,723,483,179,1048,724,484,180,1056,725,485,181,1064,726,486,182,1072,727,487,183,1080,728,488,184,1088,729,489,185,1096,730,490,186,1104,731,491,187,1112,732,492,188,1120,733,493,189,1128,734,494,190,1136,735,495,191,1144,736,192,224,128,737,193,225,129,738,194,226,130,739,195,227,131,740,196,228,132,741,197,229,133,742,198,230,134,743,199,231,135,744,200,232,136,745,201,233,137,746,202,234,138,747,203,235,139,748,204,236,140,749,205,237,141,750,206,238,142,751,207,239,143,752,208,240,144,753,209,241,145,754,210,242,146,755,211,243,147,756,212,244,148,757,213,245,149,758,214,246,150,759,215,247,151,760,216,248,152,761,217,249,153,762,218,250,154,763,219,251,155,764,220,252,156,765,221,253,157,766,222,254,158,767,223,255,159,576,368,1028,897,64,577,369,1036,905,65,578,370,1044,913,66,579,371,1052,921,67,580,372,1060,929,68,581,373,1068,937,69,582,374,1076,945,70,583,375,1084,953,71,584,376,1092,961,72,585,377,1100,969,73,586,378,1108,977,74,587,379,1116,985,75,588,380,1124,993,76,589,381,1132,1001,77,590,382,1140,1009,78,591,383,1148,1017,79,592,304,903,771,0,593,305,911,779,1,594,306,919,787,2,595,307,927,795,3,596,308,935,803,4,597,309,943,811,5,598,310,951,819,6,599,311,959,827,7,600,312,967,835,8,601,313,975,843,9,602,314,983,851,10,603,315,991,859,11,604,316,999,867,12,605,317,1007,875,13,606,318,1015,883,14,607,319,1023,891,15,608,288,1031,899,16,609,289,1039,907,17,610,290,1047,915,18,611,291,1055,923,19,612,292,1063,931,20,613,293,1071,939,21,614,294,1079,947,22,615,295,1087,955,23,616,296,1095,963,24,617,297,1103,971,25,618,298,1111,979,26,619,299,1119,987,27,620,300,1127,995,28,621,301,1135,1003,29,622,302,1143,1011,30,623,303,1151,1019,31,624,320,1029,769,80,625,321,1037,777,81,626,322,1045,785,82,627,323,1053,793,83,628,324,1061,801,84,629,325,1069,809,85,630,326,1077,817,86,631,327,1085,825,87,632,328,1093,833,88,633,329,1101,841,89,634,330,1109,849,90,635,331,1117,857,91,636,332,1125,865,92,637,333,1133,873,93,638,334,1141,881,94,639,335,1149,889,95,640,448,256,1025,641,449,257,1033,642,450,258,1041,643,451,259,1049,644,452,260,1057,645,453,261,1065,646,454,262,1073,647,455,263,1081,648,456,264,1089,649,457,265,1097,650,458,266,1105,651,459,267,1113,652,460,268,1121,653,461,269,1129,654,462,270,1137,655,463,271,1145,656,432,272,768,657,433,273,776,658,434,274,784,659,435,275,792,660,436,276,800,661,437,277,808,662,438,278,816,663,439,279,824,664,440,280,832,665,441,281,840,666,442,282,848,667,443,283,856,668,444,284,864,669,445,285,872,670,446,286,880,671,447,287,888,544,416,902,772,32,545,417,910,780,33,546,418,918,788,34,547,419,926,796,35,548,420,934,804,36,549,421,942,812,37,550,422,950,820,38,551,423,958,828,39,552,424,966,836,40,553,425,974,844,41,554,426,982,852,42,555,427,990,860,43,556,428,998,868,44,557,429,1006,876,45,558,430,1014,884,46,559,431,1022,892,47,560,464,1030,900,48,561,465,1038,908,49,562,466,1046,916,50,563,467,1054,924,51,564,468,1062,932,52,565,469,1070,940,53,566,470,1078,948,54,567,471,1086,956,55,568,472,1094,964,56,569,473,1102,972,57,570,474,1110,980,58,571,475,1118,988,59,572,476,1126,996,60,573,477,1134,1004,61,574,478,1142,1012,62,575,479,1150,1020,63,384,336,96,773,898,385,337,97,781,906,386,338,98,789,914,387,339,99,797,922,388,340,100,805,930,389,341,101,813,938,390,342,102,821,946,391,343,103,829,954,392,344,104,837,962,393,345,105,845,970,394,346,106,853,978,395,347,107,861,986,396,348,108,869,994,397,349,109,877,1002,398,350,110,885,1010,399,351,111,893,1018,400,352,112,901,1026,401,353,113,909,1034,402,354,114,917,1042,403,355,115,925,1050,404,356,116,933,1058,405,357,117,941,1066,406,358,118,949,1074,407,359,119,957,1082,408,360,120,965,1090,409,361,121,973,1098,410,362,122,981,1106,411,363,123,989,1114,412,364,124,997,1122,413,365,125,1005,1130,414,366,126,1013,1138,415,367,127,1021,1146};
__device__ const unsigned short M2L_OFFS[33] = {0,4,8,12,16,20,24,28,32,36,40,44,48,53,58,63,68,73,78,83,88,92,96,100,104,109,114,119,124,129,134,139,144};
__device__ const unsigned short M2L_LIST[144] = {84,58,16,131,85,59,17,139,86,60,18,97,87,61,19,105,88,62,20,113,89,63,21,121,90,52,22,99,91,53,23,107,92,24,28,119,93,25,29,127,94,26,30,135,95,27,31,143,72,46,103,132,4,73,47,111,140,5,74,42,98,130,112,75,43,106,138,120,76,44,115,114,128,77,45,123,122,136,78,40,102,101,6,79,41,110,109,7,80,50,32,129,81,51,33,137,82,48,34,96,83,49,35,104,68,54,118,117,8,69,55,126,125,9,70,56,134,133,10,71,57,142,141,11,64,38,12,100,0,65,39,13,108,1,66,36,14,116,2,67,37,15,124,3};


#ifndef MK_PER_PHASE
#define MK_PER_PHASE 0
#endif
constexpr int PH_PER_LAYER = 6;
constexpr int N_PHASES = 2 + PH_PER_LAYER * DEPTH;
__global__ void __launch_bounds__(NWAVES * 64, 2) hymba_fwd(Args args) {
    extern __shared__ __attribute__((aligned(16))) unsigned char lds[];
    Frame F;
    F.lds = (LAS unsigned char*)lds;
    F.G = gridDim.x; F.wave0 = __builtin_amdgcn_readfirstlane((int)threadIdx.x >> 6); F.cid = blockIdx.x; F.lok = 0; FRAME_REFRESH(F);
    for (int u = F.tid; u < (LDS_BYTES - LDSCTL_OFF) / 4; u += NWAVES * 64) ((LAS unsigned*)(F.lds + LDSCTL_OFF))[u] = 0u;
    __syncthreads();
    unsigned* barw = (unsigned*)(args.ws + WS_CTL) + CW_BAR;
    XcdBarrier bar; bar.bar = barw; bar.x = 0; bar.st = nullptr;
    if (!MK_PER_PHASE) bar = xcd_barrier_post(barw, (volatile LAS unsigned*)(F.lds + LDSCTL_OFF + 64));
    const int lo = args.ph_lo, hi = args.ph_hi;
#define IN(k) (lo <= (k) && (k) < hi)
#define SEAM(k) do { if (!MK_PER_PHASE && IN(k) && IN((k) + 1)) { unsigned* bb_ = (unsigned*)(P_WS + WS_CTL) + CW_BAR; bar.bar = bb_; FRAME_REFRESH(F); xcd_barrier(bar, F.tid == 0); } } while (0)

#define SEAML(k) do { if (!MK_PER_PHASE && IN(k) && IN((k) + 1)) { unsigned* bb_ = (unsigned*)(P_WS + WS_CTL) + CW_BAR; bar.bar = bb_; FRAME_REFRESH(F); if (F.lok) xcd_barrier_local(bar, F.tid == 0); else xcd_barrier(bar, F.tid == 0); } } while (0)
    if (IN(0)) { FRAME_REFRESH(F); p0_prologue(F); }
    SEAM(0);
    if (!MK_PER_PHASE && IN(0) && IN(1)) {
        volatile LAS int* lw = (volatile LAS int*)(F.lds + LDSCTL_OFF + 64);
        FRAME_REFRESH(F);
        if (F.tid == 0) lw[4] = xcd_local_id(bar, (unsigned)F.G);
        __syncthreads();
        const int id_ = __builtin_amdgcn_readfirstlane(lw[4]);
        if (id_ >= 0) { F.cid = id_; F.lok = 1; }
    }
#pragma unroll 1
    for (int l = 0; l < DEPTH; ++l) {
        const int pb = 1 + PH_PER_LAYER * l;
        if (IN(pb + 0)) {
            FRAME_REFRESH(F);
            pg8::Gemm g{P_XN, P_WIN + (size_t)l * NPROJ * D, T, NPROJ, D}; pg8::StaticOrder S; S.init(T, NPROJ, F.G, (int)F.bid);
            pg8::EpiProj E{P_PROJ, P_rope, NPROJ, QSCALE, l == 0 ? (const float*)nullptr : (const float*)P_ST(2 * l - 1), P_CV + CV_C1IN + l * NPROJ, P_CV + CV_C2IN + l * NPROJ, SLAB_PADP / 2, (P_IN + 63) / 64 * 64};
            pg8::gemm_phase<pg8::EpiProj, pg8::StaticOrder, true, true>(F.lds, g, S, E, F.wave);
        }
        SEAML(pb + 0);
        if (IN(pb + 1)) {
            FRAME_REFRESH(F);
            if (l == 0) fold_vectors_reduce(F);
#define XUNITS(u, N) for (int k_ = 0, u = F.lok ? (F.bid & 7) * ((N) / 8) + (F.bid >> 3) : F.bid; F.lok ? k_ < (N) / 256 : u < (N); ++k_, u += F.lok ? 32 : F.G)
            XUNITS(u, 256) m1_compress(F, l, u);
            XUNITS(u, 512) m1_vt(F, u);
            XUNITS(u, 512) m1_gla_pool(F, l, u);
        }
        if (l == 0) SEAM(pb + 1); else SEAML(pb + 1);
        if (IN(pb + 2)) {
            FRAME_REFRESH(F);
            if (F.lok) {
                const int x = F.bid & 7, r = F.bid >> 3;
#pragma unroll 1
                for (int i = __builtin_amdgcn_readfirstlane((int)M2L_OFFS[r]), i1 = __builtin_amdgcn_readfirstlane((int)M2L_OFFS[r + 1]); i < i1; ++i) { const int lid = __builtin_amdgcn_readfirstlane((int)M2L_LIST[i]);
                    if (lid < 96) { const int hh = lid % 3, t_ = lid / 3; m2_nsa(F, ((t_ >> 2) * 32 + 4 * x + (t_ & 3)) * 3 + hh); } else m2_gla(F, l, (lid - 96) + 48 * x); }
            } else {
#pragma unroll 1
            for (int w = F.bid; w < 256; w += F.G) {
#pragma unroll 1
                for (int i = __builtin_amdgcn_readfirstlane((int)M2_OFFS[w]), i1 = __builtin_amdgcn_readfirstlane((int)M2_OFFS[w + 1]); i < i1; ++i) { const int id = __builtin_amdgcn_readfirstlane((int)M2_LIST[i]);
                    if (id < 768) m2_nsa(F, id); else m2_gla(F, l, id - 768); } }
            }
        }
        SEAML(pb + 2);
        if (IN(pb + 3)) {
            FRAME_REFRESH(F);
            pg8::Gemm g{P_MIXED, P_WOUT + (size_t)l * D * D, T, D, D, SLAB_PADM}; pg8::StaticOrder S; S.init(T, D, F.G, (int)F.bid);
            const int kin = l == 0 ? 0 : 2 * l - 1;
            pg8::EpiRes E{l == 0 ? P_x : (const float*)nullptr, P_XN, P_ST(0), P_GB + kin * 2048, D, kin, 2 * l, ALPHA};
            pg8::gemm_phase<pg8::EpiRes, pg8::StaticOrder, true, true>(F.lds, g, S, E, F.wave);
        }
        SEAML(pb + 3);
        if (IN(pb + 4)) {
            FRAME_REFRESH(F);
            pg8::Gemm g{P_XN, P_WUP + (size_t)l * D * FF, T, FF, D}; pg8::StaticOrder S; S.init(T, FF, F.G, (int)F.bid);
            pg8::EpiRelu2 E{P_U, FF, P_ST(2 * l), P_CV + CV_C1UP + l * FF, P_CV + CV_C2UP + l * FF};
            pg8::gemm_phase<pg8::EpiRelu2, pg8::StaticOrder, true, true>(F.lds, g, S, E, F.wave);
        }
        SEAML(pb + 4);
        if (IN(pb + 5)) {
            FRAME_REFRESH(F);
            pg8::Gemm g{P_U, P_WDN + (size_t)l * D * FF, T, D, FF}; pg8::StaticOrder S; S.init(T, D, F.G, (int)F.bid);
            pg8::EpiRes E{(const float*)nullptr, P_XN, P_ST(0), P_GB + (2 * l) * 2048, D, 2 * l, 2 * l + 1, ALPHA};
            pg8::gemm_phase<pg8::EpiRes, pg8::StaticOrder, true, true>(F.lds, g, S, E, F.wave);
        }
        if (l + 1 < DEPTH) SEAML(pb + 5); else SEAM(pb + 5);
    }
    if (IN(1 + PH_PER_LAYER * DEPTH)) { FRAME_REFRESH(F); final_ln_phase(F, P_ST(2 * DEPTH - 1), P_ln2_g + (DEPTH - 1) * D, P_ln2_b + (DEPTH - 1) * D); }
#undef IN
#undef SEAM
}

extern "C" void kernel_launch(void* const* d_in, const int* in_sizes, int n_in, void* d_out, int out_size, void* d_ws, size_t ws_size, hipStream_t stream) {
    static int grid = 0;
    if (grid == 0) {
        if (n_in != 17 || in_sizes[0] != T * D || out_size != T * D || ws_size < WS_END) { fprintf(stderr, "kernel_launch: unexpected problem (n_in %d, in0 %d, out %d, ws %zu); nothing launched\n", n_in, n_in > 0 ? in_sizes[0] : -1, out_size, ws_size); grid = -1; return; }
        int dev = 0, cus = 0, per_cu = 0;
        if (hipGetDevice(&dev) != hipSuccess || hipDeviceGetAttribute(&cus, hipDeviceAttributeMultiprocessorCount, dev) != hipSuccess) { grid = -1; return; }
        if (hipFuncSetAttribute((const void*)hymba_fwd, hipFuncAttributeMaxDynamicSharedMemorySize, LDS_BYTES) != hipSuccess) { fprintf(stderr, "kernel_launch: hipFuncSetAttribute failed\n"); grid = -1; return; }
        if (hipOccupancyMaxActiveBlocksPerMultiprocessor(&per_cu, (const void*)hymba_fwd, NWAVES * 64, LDS_BYTES) != hipSuccess || per_cu < 1) { fprintf(stderr, "kernel_launch: occupancy query says %d blocks per CU\n", per_cu); per_cu = 1; }
        (void)hipGetLastError();
        grid = cus;
    }
    if (grid < 0) return;
    if (hipMemsetAsync((char*)d_ws + WS_CTL, 0, CTL_ZERO_BYTES, stream) != hipSuccess) { fprintf(stderr, "kernel_launch: memset failed\n"); return; }
    Args a{};
    for (int i = 0; i < 17; ++i) a.in[i] = (const float*)d_in[i];
    a.out = (float*)d_out; a.ws = (unsigned char*)d_ws;
#if MK_PER_PHASE
    for (int p = 0; p < N_PHASES; ++p) { a.ph_lo = p; a.ph_hi = p + 1; hipLaunchKernelGGL(hymba_fwd, dim3(grid), dim3(NWAVES * 64), LDS_BYTES, stream, a); }
#else
    a.ph_lo = 0; a.ph_hi = N_PHASES;
    hipLaunchKernelGGL(hymba_fwd, dim3(grid), dim3(NWAVES * 64), LDS_BYTES, stream, a);
#endif
    const hipError_t le = hipPeekAtLastError();
    if (le != hipSuccess) fprintf(stderr, "kernel_launch: launch failed: %s\n", hipGetErrorName(le));
}
```

```cpp
#include <hip/hip_runtime.h>
#include <cstdio>
#include <cstdint>
__device__ __forceinline__ float shx(float v, int mask, int lane) { return __builtin_bit_cast(float, __builtin_amdgcn_ds_bpermute((lane ^ mask) << 2, __builtin_bit_cast(int, v))); }
__device__ __forceinline__ unsigned shxu(unsigned v, int mask, int lane) { return (unsigned)__builtin_amdgcn_ds_bpermute((lane ^ mask) << 2, (int)v); }
namespace pg8 {
#define PG8_LAS __attribute__((address_space(3)))
typedef unsigned short bf16_t;
typedef short bf16x8 __attribute__((ext_vector_type(8)));
typedef float f32x4 __attribute__((ext_vector_type(4)));
typedef unsigned u32x4 __attribute__((ext_vector_type(4)));
constexpr int BM = 256, BK = 64, HALF = 128, HTB = HALF * BK * 2  , STAGE_BYTES = 8 * HTB, NXCD = 8, WGM = 8;

__host__ __device__ __forceinline__ int lds_byte(int r, int c) { const int st = (r >> 4) * 2 + (c >> 5), rr = r & 15, cc = c & 31, ob = rr * 64 + cc * 2; return st * 1024 + (ob ^ (((ob >> 9) & 1) << 5)); }
__host__ __device__ __forceinline__ void stage_rc(int b, int& R, int& C) { const int st = b / 1024, sb = b % 1024, swz = sb ^ (((sb >> 9) & 1) << 5); R = (st >> 1) * 16 + swz / 64; C = (st & 1) * 32 + (swz % 64) / 2; }
__host__ __device__ __forceinline__ int perm32(int rho) { const int n = rho >> 4, i = rho & 15; return 8 * (i >> 2) + 4 * n + (i & 3); }

struct Unit { int pm, pn; };
struct Gemm { const bf16_t* A; const bf16_t* Bt; int M, N, K; size_t apad = 0; };

struct StaticOrder {
    int nM, nN, nwg, G, c;
    __host__ __device__ void init(int M, int N, int G_, int c_) { nM = M / BM; nN = N / BM; nwg = nM * nN; G = G_; c = c_; }
    __host__ __device__ bool next(int i, Unit& u) const {
        const long L = (long)i * G + c; if (L >= nwg) return false;
        int wgid = (int)L; { const int q = nwg / NXCD, r = nwg % NXCD, xcd = wgid % NXCD, off = wgid / NXCD; wgid = (xcd < r ? xcd * (q + 1) : r * (q + 1) + (xcd - r) * q) + off; }
        const int nig = WGM * nN, gid = wgid / nig, fm = gid * WGM, gsz = (nM - fm) < WGM ? (nM - fm) : WGM;
        u.pm = fm + ((wgid % nig) % gsz); u.pn = (wgid % nig) / gsz; return true;
    }
    __device__ __forceinline__ void a_ready(const Unit&) const {}
    __device__ __forceinline__ void done(const Unit&) const {}
};

__device__ __forceinline__ unsigned cvt_pk_bf16(float lo, float hi) { unsigned r; asm volatile("v_cvt_pk_bf16_f32 %0, %1, %2" : "=v"(r) : "v"(lo), "v"(hi)); return r; }
typedef float f32x2 __attribute__((ext_vector_type(2)));
constexpr float LNF_EPS = 1e-5f;
__device__ __forceinline__ void row_stats_finish(f32x2 v, float& mu, float& rstd, int lane) {
    float s = v[0], ss = v[1];
    s += shx(s, 16, lane); ss += shx(ss, 16, lane); s += shx(s, 32, lane); ss += shx(ss, 32, lane);
    mu = s * (1.0f / 1024.0f); const float var = fmaxf(ss * (1.0f / 1024.0f) - mu * mu, 0.f); rstd = __builtin_amdgcn_rsqf(var + LNF_EPS);
}
__device__ __forceinline__ void row_stats8_load(const float* st, int row0, int fq, f32x2 (&raw)[8]) {
#pragma unroll
    for (int i = 0; i < 8; ++i) raw[i] = *(const f32x2*)(st + (size_t)(row0 + (i >> 2) * HALF + (i & 3) * 16) * 8 + 2 * fq);
}
struct EpiProj {
    static constexpr bool PERM = true, AFTER_DRAIN = false, CONTIG = true;
    bf16_t* O; const float* rope; int ldc; float qscale; const float* st; const float* c1; const float* c2; size_t opad; int ncol;
    __device__ __forceinline__ void operator()(const f32x4 (&acc)[2][2][4][2], const Unit& u, int wr, int wc, int fr, int fq, PG8_LAS unsigned char*, int) const {
        const int row0 = u.pm * BM + wr * 64 + fr;
        const int cg0 = u.pn * BM + wc * 64, h64 = cg0 >> 6;
        if (cg0 >= ncol) return;
        const bool roped = (h64 < 6 || (h64 < 18 && (((h64 - 6) >> 1) & 1) == 0));
        const float sc = (cg0 < 384) ? qscale : 1.0f;
        f32x4 k1[2][2], k2[2][2];
#pragma unroll
        for (int bj = 0; bj < 2; ++bj)
#pragma unroll
            for (int n = 0; n < 2; ++n) { k1[bj][n] = (f32x4){0.f, 0.f, 0.f, 0.f}; k2[bj][n] = k1[bj][n];
                if (st) { k1[bj][n] = *(const f32x4*)(c1 + cg0 + bj * 32 + 8 * fq + 4 * n); k2[bj][n] = *(const f32x4*)(c2 + cg0 + bj * 32 + 8 * fq + 4 * n); } }
        f32x2 raw[8];
#pragma unroll
        for (int i = 0; i < 8; ++i) raw[i] = (f32x2){0.f, 0.f};
        if (st) row_stats8_load(st, row0, fq, raw);
        const bool odd = fr & 1;
        bf16_t* const obase = O + (size_t)(u.pm >> 4) * opad + (size_t)(row0 - (fr & 1)) * ldc + cg0 + (fr & 1) * 32 + 8 * fq;
#pragma unroll
        for (int ai = 0; ai < 2; ++ai)
#pragma unroll
            for (int m = 0; m < 4; ++m) {
                const int row = row0 + ai * HALF + m * 16;
                float mu = 0.f, rs = 1.f; if (st) row_stats_finish(raw[ai * 4 + m], mu, rs, fr + 16 * fq);
                u32x4 w[2];
#pragma unroll
                for (int bj = 0; bj < 2; ++bj) {
                    f32x4 v0 = (acc[ai][bj][m][0] - k1[bj][0] * mu) * rs + k2[bj][0], v1 = (acc[ai][bj][m][1] - k1[bj][1] * mu) * rs + k2[bj][1];
                    if (bj == 0 && roped) {
                        f32x4 o0, o1;
#pragma unroll
                        for (int e = 0; e < 4; ++e) { o0[e] = shx(v0[e], 16, fr + 16 * fq); o1[e] = shx(v1[e], 16, fr + 16 * fq); }
                        if (fq < 2) {
                            const float* rp = rope + (size_t)(row & 2047) * 16;
                            const f32x4 c0 = *(const f32x4*)(rp), cc1 = *(const f32x4*)(rp + 4), s0 = *(const f32x4*)(rp + 8), s1 = *(const f32x4*)(rp + 12);
                            const float sg = (fq == 0) ? -1.0f : 1.0f;
                            v0 = v0 * c0 + o0 * (s0 * sg); v1 = v1 * cc1 + o1 * (s1 * sg);
                        }
                    }
                    v0 = v0 * sc; v1 = v1 * sc;
                    w[bj].x = cvt_pk_bf16(v0[0], v0[1]); w[bj].y = cvt_pk_bf16(v0[2], v0[3]); w[bj].z = cvt_pk_bf16(v1[0], v1[1]); w[bj].w = cvt_pk_bf16(v1[2], v1[3]);
                }
                u32x4 wa, wb;
#pragma unroll
                for (int e = 0; e < 4; ++e) { const unsigned snd = odd ? w[0][e] : w[1][e];
                    const unsigned rcv = (unsigned)__builtin_amdgcn_update_dpp(0, (int)snd, 0xB1, 0xF, 0xF, true);
                    wa[e] = odd ? rcv : w[0][e]; wb[e] = odd ? w[1][e] : rcv; }
                bf16_t* rowp = obase + (size_t)(ai * HALF + m * 16) * ldc;
                *(u32x4*)rowp = wa; *(u32x4*)(rowp + ldc) = wb;
            }
    }
};
struct EpiRelu2 {
    static constexpr bool PERM = true, AFTER_DRAIN = false, CONTIG = true;
    bf16_t* O; int ldc; const float* st; const float* c1; const float* c2;
    __device__ __forceinline__ void operator()(const f32x4 (&acc)[2][2][4][2], const Unit& u, int wr, int wc, int fr, int fq, PG8_LAS unsigned char* l, int t) const { run<true>(acc, u, wr, wc, fr, fq, l, t); }
    template <bool STORE>
    __device__ __forceinline__ void run(const f32x4 (&acc)[2][2][4][2], const Unit& u, int wr, int wc, int fr, int fq, PG8_LAS unsigned char*, int) const {
        const int row0 = u.pm * BM + wr * 64 + fr; const int col0 = u.pn * BM + wc * 64 + 8 * fq;
        f32x4 k1[2][2], k2[2][2];
#pragma unroll
        for (int bj = 0; bj < 2; ++bj)
#pragma unroll
            for (int n = 0; n < 2; ++n) { k1[bj][n] = *(const f32x4*)(c1 + col0 + bj * 32 + 4 * n); k2[bj][n] = *(const f32x4*)(c2 + col0 + bj * 32 + 4 * n); }
        f32x2 raw[8]; row_stats8_load(st, row0, fq, raw);
        const bool odd = fr & 1;
        bf16_t* const obase = O + (size_t)(row0 - (fr & 1)) * ldc + col0 + (fr & 1) * 32;
#pragma unroll
        for (int ai = 0; ai < 2; ++ai)
#pragma unroll
            for (int m = 0; m < 4; ++m) { float mu, rs; row_stats_finish(raw[ai * 4 + m], mu, rs, fr + 16 * fq);
                u32x4 w[2];
#pragma unroll
                for (int bj = 0; bj < 2; ++bj) { f32x4 v0 = (acc[ai][bj][m][0] - k1[bj][0] * mu) * rs + k2[bj][0], v1 = (acc[ai][bj][m][1] - k1[bj][1] * mu) * rs + k2[bj][1];
#pragma unroll
                    for (int e = 0; e < 4; ++e) { const float a = fmaxf(v0[e], 0.f), b = fmaxf(v1[e], 0.f); v0[e] = a * a; v1[e] = b * b; }
                    w[bj].x = cvt_pk_bf16(v0[0], v0[1]); w[bj].y = cvt_pk_bf16(v0[2], v0[3]); w[bj].z = cvt_pk_bf16(v1[0], v1[1]); w[bj].w = cvt_pk_bf16(v1[2], v1[3]); }
                u32x4 wa, wb;
#pragma unroll
                for (int e = 0; e < 4; ++e) { const unsigned snd = odd ? w[0][e] : w[1][e];
                    const unsigned rcv = (unsigned)__builtin_amdgcn_update_dpp(0, (int)snd, 0xB1, 0xF, 0xF, true);
                    wa[e] = odd ? rcv : w[0][e]; wb[e] = odd ? w[1][e] : rcv; }
                bf16_t* rowp = obase + (size_t)(ai * HALF + m * 16) * ldc;
                if (STORE) { *(u32x4*)rowp = wa; *(u32x4*)(rowp + ldc) = wb; } else { asm volatile("" :: "v"(wa)); asm volatile("" :: "v"(wb)); } }
    }
};
struct EpiRes {
    static constexpr bool PERM = true, AFTER_DRAIN = false, CONTIG = true;
    const float* resf; bf16_t* xb; float* stb; const float* gb; int ldc, k_in, k_out; float alpha;
    __device__ __forceinline__ void operator()(f32x4 (&acc)[2][2][4][2], const Unit& u, int wr, int wc, int fr, int fq, PG8_LAS unsigned char* lds, int tid) const {
        const int col0 = u.pn * BM + wc * 64 + 8 * fq;
        const float* st_in = stb + (size_t)(k_in & 1) * (32768 * 8); float* st_out = stb + (size_t)(k_out & 1) * (32768 * 8);
        PG8_LAS f32x2* P = (PG8_LAS f32x2*)(lds + STAGE_BYTES);
        f32x4 gv[2][2], bv[2][2];
#pragma unroll
        for (int bj = 0; bj < 2; ++bj)
#pragma unroll
            for (int n = 0; n < 2; ++n) { gv[bj][n] = (f32x4){1.f, 1.f, 1.f, 1.f}; bv[bj][n] = (f32x4){0.f, 0.f, 0.f, 0.f};
                if (!resf) { gv[bj][n] = *(const f32x4*)(gb + col0 + bj * 32 + n * 4); bv[bj][n] = *(const f32x4*)(gb + 1024 + col0 + bj * 32 + n * 4); } }
        int frl = fr; asm volatile("" : "+v"(frl));
        const bool odd = frl & 1;
        const int colw = u.pn * BM + wc * 64 + (frl & 1) * 32 + 8 * fq;
        u32x4 rwq[3][2]; f32x2 stq[3];
#define EPIRES_REQ(i_) do { const int row_ = u.pm * BM + ((i_) >> 2) * HALF + wr * 64 + ((i_) & 3) * 16 + frl; const size_t off_ = (size_t)(row_ - (frl & 1)) * ldc + colw; \
            if (!resf) { stq[(i_) % 3] = *(const f32x2*)(st_in + (size_t)row_ * 8 + 2 * fq); \
                rwq[(i_) % 3][0] = *(const u32x4*)(xb + off_); rwq[(i_) % 3][1] = *(const u32x4*)(xb + off_ + ldc); } } while (0)
        EPIRES_REQ(0); EPIRES_REQ(1);
        PG8_LAS f32x2* const Pl = P + (wr * 64 + frl) * 4 + wc;
#pragma unroll
        for (int i = 0; i < 8; ++i) { const int ai = i >> 2, m = i & 3;
            const int rl = ai * HALF + wr * 64 + m * 16 + frl, row = u.pm * BM + rl; const size_t off = (size_t)row * ldc + col0;
            if (i + 2 < 8) EPIRES_REQ(i + 2);
            float mu = 0.f, rs = 1.f; if (!resf) row_stats_finish(stq[i % 3], mu, rs, fr + 16 * fq);
            u32x4 own[2];
            if (!resf) {
#pragma unroll
                for (int e = 0; e < 4; ++e) { const unsigned a_ = rwq[i % 3][0][e], b_ = rwq[i % 3][1][e]; const unsigned snd = odd ? a_ : b_;
                    const unsigned rcv = (unsigned)__builtin_amdgcn_update_dpp(0, (int)snd, 0xB1, 0xF, 0xF, true);
                    own[0][e] = odd ? rcv : a_; own[1][e] = odd ? b_ : rcv; }
            }
            float s = 0.f, ss = 0.f; u32x4 wo[2];
#pragma unroll
            for (int bj = 0; bj < 2; ++bj) {
#pragma unroll
                for (int n = 0; n < 2; ++n) { f32x4 r;
                    if (resf) r = *(const f32x4*)(resf + off + bj * 32 + n * 4);
                    else { const unsigned w0 = own[bj][2 * n], w1 = own[bj][2 * n + 1];
                           r[0] = __builtin_bit_cast(float, w0 << 16); r[1] = __builtin_bit_cast(float, w0 & 0xffff0000u); r[2] = __builtin_bit_cast(float, w1 << 16); r[3] = __builtin_bit_cast(float, w1 & 0xffff0000u); }
                    const f32x4 h = (r - mu) * rs * gv[bj][n] + bv[bj][n];
                    const f32x4 y = h * alpha + acc[ai][bj][m][n];
                    const unsigned p0 = cvt_pk_bf16(y[0], y[1]), p1 = cvt_pk_bf16(y[2], y[3]); wo[bj][2 * n] = p0; wo[bj][2 * n + 1] = p1;
                    const float y0 = __builtin_bit_cast(float, p0 << 16), y1 = __builtin_bit_cast(float, p0 & 0xffff0000u), y2 = __builtin_bit_cast(float, p1 << 16), y3 = __builtin_bit_cast(float, p1 & 0xffff0000u);
                    s += (y0 + y1) + (y2 + y3); ss += (y0 * y0 + y1 * y1) + (y2 * y2 + y3 * y3); } }
            { u32x4 wa, wb;
#pragma unroll
              for (int e = 0; e < 4; ++e) { const unsigned snd = odd ? wo[0][e] : wo[1][e];
                  const unsigned rcv = (unsigned)__builtin_amdgcn_update_dpp(0, (int)snd, 0xB1, 0xF, 0xF, true);
                  wa[e] = odd ? rcv : wo[0][e]; wb[e] = odd ? wo[1][e] : rcv; }
              bf16_t* wp = xb + (size_t)(row - (frl & 1)) * ldc + colw;
              *(u32x4*)wp = wa; *(u32x4*)(wp + ldc) = wb; }
            s += shx(s, 16, fr + 16 * fq); s += shx(s, 32, fr + 16 * fq); ss += shx(ss, 16, fr + 16 * fq); ss += shx(ss, 32, fr + 16 * fq);
            if (fq == 0) Pl[(ai * HALF + m * 16) * 4] = (f32x2){s, ss}; }
#undef EPIRES_REQ
        asm volatile("s_waitcnt lgkmcnt(0)" ::: "memory"); __builtin_amdgcn_s_barrier(); asm volatile("" ::: "memory");
        asm volatile("" : "+v"(tid));
        if (tid < 256) { const f32x2 a = P[tid * 4 + 0], b = P[tid * 4 + 1], c = P[tid * 4 + 2], d = P[tid * 4 + 3];
            *(f32x2*)(st_out + (size_t)(u.pm * BM + tid) * 8 + 2 * u.pn) = (f32x2){(a[0] + b[0]) + (c[0] + d[0]), (a[1] + b[1]) + (c[1] + d[1])}; }
    }
};
template <class Epi, class Sched, bool ALIGN_EPI = false, bool SP2 = false>
__device__ __forceinline__ void gemm_phase(PG8_LAS unsigned char* lds, const Gemm g, const Sched& S, const Epi& E, int wave_id) {
    unsigned mk_ = ~0u; asm volatile("" : "+s"(mk_)); int lane_ = (int)__builtin_amdgcn_mbcnt_hi(mk_, __builtin_amdgcn_mbcnt_lo(mk_, 0u)); asm volatile("" : "+v"(lane_)); asm volatile("" : "+s"(wave_id));
    const int tid = wave_id * 64 + lane_, wid = wave_id, lane = tid & 63, wr = wid >> 2, wc = wid & 3, fr = lane & 15, fq = lane >> 4;
    const int K = g.K, nt = K / BK;
    unsigned voffA[2], voffB[2];
#pragma unroll
    for (int i = 0; i < 2; ++i) { int R, C; stage_rc(tid * 16 + i * 8192, R, C); const int r5 = Epi::PERM ? perm32(R & 31) : (R & 31); const int Rb = Epi::CONTIG ? ((R >> 5) * 64 + r5) : ((R & ~31) + r5);
        voffA[i] = (unsigned)(R * K + C) * 2u; voffB[i] = (unsigned)(Rb * K + C) * 2u; }
    const size_t kstep = (size_t)(BK * 2);
    const size_t hstep = (size_t)HALF * K * 2;
    const size_t hstepB = Epi::CONTIG ? (size_t)32 * K * 2 : hstep;
    const size_t tstep = 2 * hstep;
    const unsigned ldsw = (unsigned)wid * 1024u;
    const int aoff = lds_byte(wr * 64 + fr, fq * 8), boff = lds_byte(wc * 32 + fr, fq * 8);
#define PG8_SA(b, h) (((b) * 2 + (h)) * HTB)
#define PG8_SB(b, h) ((4 + (b) * 2 + (h)) * HTB)
#define PG8_STAGE(bufoff, gbase, voff) do { _Pragma("unroll") for (int _i = 0; _i < 2; ++_i) \
        __builtin_amdgcn_global_load_lds((const unsigned*)((const char*)(gbase) + (voff)[_i]), (PG8_LAS unsigned*)(lds + (bufoff) + ldsw + _i * 8192), 16, 0, 0); } while (0)
#define PG8_LDA(dst, b, h) do { _Pragma("unroll") for (int m = 0; m < 4; ++m) _Pragma("unroll") for (int k = 0; k < 2; ++k) dst[m][k] = *(const PG8_LAS bf16x8*)(lds + PG8_SA(b, h) + aoff + m * 2048 + k * 1024); } while (0)
#define PG8_LDB(dst, b, h) do { _Pragma("unroll") for (int n = 0; n < 2; ++n) _Pragma("unroll") for (int k = 0; k < 2; ++k) dst[n][k] = *(const PG8_LAS bf16x8*)(lds + PG8_SB(b, h) + boff + n * 2048 + k * 1024); } while (0)
#define PG8_MMA(ai, bj, At, Bt) do { __builtin_amdgcn_s_setprio(1); _Pragma("unroll") for (int m = 0; m < 4; ++m) _Pragma("unroll") for (int n = 0; n < 2; ++n) _Pragma("unroll") for (int k = 0; k < 2; ++k) \
        acc[ai][bj][m][n] = __builtin_amdgcn_mfma_f32_16x16x32_bf16(Bt[n][k], At[m][k], acc[ai][bj][m][n], 0, 0, 0); __builtin_amdgcn_s_setprio(0); } while (0)
#define PG8_WAIT_V(n) asm volatile("s_waitcnt vmcnt(" #n ")" ::: "memory")
#define PG8_WAIT_L(n) asm volatile("s_waitcnt lgkmcnt(" #n ")" ::: "memory")
#define PG8_BAR __builtin_amdgcn_s_barrier()
#define PG8_SCHED __builtin_amdgcn_sched_barrier(0)
    Unit cur, nxt; int ui = 0;
    if (!S.next(0, cur)) return;
    f32x4 acc[2][2][4][2];
#pragma unroll
    for (int a = 0; a < 2; ++a)
#pragma unroll
        for (int b = 0; b < 2; ++b)
#pragma unroll
            for (int m = 0; m < 4; ++m)
#pragma unroll
                for (int n = 0; n < 2; ++n) acc[a][b][m][n] = (f32x4){0.f, 0.f, 0.f, 0.f};
    bf16x8 At[4][2], B0[2][2], B1[2][2];
    const char* cA = (const char*)g.A + (size_t)cur.pm * tstep + (size_t)(cur.pm >> 4) * g.apad; const char* cB = (const char*)g.Bt + (size_t)cur.pn * tstep;
    S.a_ready(cur);
    if constexpr (SP2) {
        PG8_STAGE(PG8_SB(0, 0), cB, voffB); PG8_STAGE(PG8_SB(0, 1), cB + hstepB, voffB); PG8_STAGE(PG8_SA(0, 0), cA, voffA); PG8_STAGE(PG8_SA(0, 1), cA + hstep, voffA);
        if (wr == 1) PG8_BAR;
        PG8_WAIT_V(2); PG8_BAR;
        PG8_STAGE(PG8_SB(1, 0), cB + kstep, voffB); PG8_STAGE(PG8_SA(1, 0), cA + kstep, voffA); PG8_STAGE(PG8_SB(1, 1), cB + hstepB + kstep, voffB);
        PG8_WAIT_V(6); PG8_BAR;
    } else {
        PG8_STAGE(PG8_SB(0, 0), cB, voffB); PG8_STAGE(PG8_SA(0, 0), cA, voffA); PG8_STAGE(PG8_SB(0, 1), cB + hstepB, voffB); PG8_STAGE(PG8_SA(0, 1), cA + hstep, voffA);
        if (wr == 1) PG8_BAR;
        PG8_WAIT_V(4); PG8_BAR;
        PG8_STAGE(PG8_SB(1, 0), cB + kstep, voffB); PG8_STAGE(PG8_SA(1, 0), cA + kstep, voffA); PG8_STAGE(PG8_SB(1, 1), cB + hstepB + kstep, voffB);
        PG8_WAIT_V(6); PG8_BAR;
    }
    for (;;) {
        const bool has_next = S.next(ui + 1, nxt);
        const char* nA = has_next ? (const char*)g.A + (size_t)nxt.pm * tstep + (size_t)(nxt.pm >> 4) * g.apad : cA; const char* nB = has_next ? (const char*)g.Bt + (size_t)nxt.pn * tstep : cB;
        for (int t = 0; t < nt; t += 2) {
            const bool last = (t == nt - 2);
            const char* a1 = cA + (size_t)(t + 1) * kstep;
            const char* a2 = last ? nA : cA + (size_t)(t + 2) * kstep; const char* b2 = last ? nB : cB + (size_t)(t + 2) * kstep;
            const char* a3 = a2 + kstep; const char* b3 = b2 + kstep;
            if (last && has_next) S.a_ready(nxt);
            if constexpr (SP2) {
            PG8_LDB(B0, 0, 0); PG8_LDB(B1, 0, 1); PG8_SCHED; PG8_LDA(At, 0, 0); PG8_STAGE(PG8_SA(1, 1), a1 + hstep, voffA);
            PG8_WAIT_V(8); PG8_WAIT_L(0); PG8_BAR; PG8_MMA(0, 0, At, B0); PG8_MMA(0, 1, At, B1); PG8_BAR; PG8_SCHED;
            PG8_LDA(At, 0, 1); PG8_STAGE(PG8_SB(0, 0), b2, voffB); PG8_STAGE(PG8_SB(0, 1), b2 + hstepB, voffB); PG8_STAGE(PG8_SA(0, 0), a2, voffA);
            PG8_WAIT_V(8); PG8_WAIT_L(0); PG8_BAR; PG8_MMA(1, 0, At, B0); PG8_MMA(1, 1, At, B1); PG8_BAR; PG8_SCHED;
            PG8_LDB(B0, 1, 0); PG8_LDB(B1, 1, 1); PG8_SCHED; PG8_LDA(At, 1, 0); PG8_STAGE(PG8_SA(0, 1), a2 + hstep, voffA);
            PG8_WAIT_V(8); PG8_WAIT_L(0); PG8_BAR; PG8_MMA(0, 0, At, B0); PG8_MMA(0, 1, At, B1); PG8_BAR; PG8_SCHED;
            PG8_LDA(At, 1, 1); PG8_STAGE(PG8_SB(1, 0), b3, voffB); PG8_STAGE(PG8_SB(1, 1), b3 + hstepB, voffB); PG8_STAGE(PG8_SA(1, 0), a3, voffA);
            PG8_WAIT_V(8); PG8_WAIT_L(0); PG8_BAR; PG8_MMA(1, 0, At, B0); PG8_MMA(1, 1, At, B1); PG8_BAR; PG8_SCHED;
            } else {
            PG8_LDB(B0, 0, 0); PG8_SCHED; PG8_LDA(At, 0, 0); PG8_STAGE(PG8_SA(1, 1), a1 + hstep, voffA);
            PG8_WAIT_L(8); PG8_BAR; PG8_WAIT_L(0); PG8_MMA(0, 0, At, B0); PG8_BAR; PG8_SCHED;
            PG8_LDB(B1, 0, 1); PG8_STAGE(PG8_SB(0, 0), b2, voffB);
            PG8_BAR; PG8_WAIT_L(0); PG8_MMA(0, 1, At, B1); PG8_BAR;
            PG8_LDA(At, 0, 1); PG8_STAGE(PG8_SA(0, 0), a2, voffA);
            PG8_BAR; PG8_WAIT_L(0); PG8_MMA(1, 0, At, B0); PG8_BAR; PG8_SCHED;
            PG8_STAGE(PG8_SB(0, 1), b2 + hstepB, voffB);
            PG8_WAIT_V(6); PG8_BAR; PG8_MMA(1, 1, At, B1); PG8_BAR;
            PG8_LDB(B0, 1, 0); PG8_SCHED; PG8_LDA(At, 1, 0); PG8_STAGE(PG8_SA(0, 1), a2 + hstep, voffA);
            PG8_WAIT_L(8); PG8_BAR; PG8_WAIT_L(0); PG8_MMA(0, 0, At, B0); PG8_BAR; PG8_SCHED;
            PG8_LDB(B1, 1, 1); PG8_STAGE(PG8_SB(1, 0), b3, voffB);
            PG8_BAR; PG8_WAIT_L(0); PG8_MMA(0, 1, At, B1); PG8_BAR;
            PG8_LDA(At, 1, 1); PG8_STAGE(PG8_SA(1, 0), a3, voffA);
            PG8_BAR; PG8_WAIT_L(0); PG8_MMA(1, 0, At, B0); PG8_BAR; PG8_SCHED;
            PG8_STAGE(PG8_SB(1, 1), b3 + hstepB, voffB);
            PG8_WAIT_V(6); PG8_BAR; PG8_MMA(1, 1, At, B1); PG8_BAR;
            }
        }
        if constexpr (ALIGN_EPI) { if (wr == 0) PG8_BAR; }
        if constexpr (!Epi::AFTER_DRAIN) { E(acc, cur, wr, wc, fr, fq, lds, tid); S.done(cur); }
        if (!has_next) break;
#pragma unroll
        for (int a = 0; a < 2; ++a)
#pragma unroll
            for (int b = 0; b < 2; ++b)
#pragma unroll
                for (int m = 0; m < 4; ++m)
#pragma unroll
                    for (int n = 0; n < 2; ++n) acc[a][b][m][n] = (f32x4){0.f, 0.f, 0.f, 0.f};
        cur = nxt; cA = nA; cB = nB; ++ui;
        if constexpr (ALIGN_EPI) { if (wr == 1) PG8_BAR; }
    }
    PG8_WAIT_V(0);
    if constexpr (!ALIGN_EPI) { if (wr == 0) PG8_BAR; }
    PG8_BAR;
    if constexpr (Epi::AFTER_DRAIN) { E.fused(acc, cur, wr, wc, fr, fq, lds, wid, lane); S.done(cur); }
#undef PG8_SA
#undef PG8_SB
#undef PG8_STAGE
#undef PG8_LDA
#undef PG8_LDB
#undef PG8_MMA
#undef PG8_WAIT_V
#undef PG8_WAIT_L
#undef PG8_BAR
#undef PG8_SCHED
}
}

constexpr int NWAVES = 8;
constexpr int BATCH = 16, SEQ = 2048, D = 1024, DEPTH = 4, T = BATCH * SEQ;
constexpr int P_IN = 2594, NPROJ = 2816, FF = 4096;
constexpr int C_Q = 0, C_KV = 384, C_GQ = 1152, C_GK = 1344, C_GV = 1536, C_OG = 1920, C_PU = 2304, C_GLR = 2560, C_GATE = 2576;
constexpr float LN_EPS = 1e-5f, RMS_EPS = 1e-6f;
constexpr float ALPHA = 1.6817928305074290f;
constexpr float QSCALE = 0.125f * 1.4426950408889634f;

constexpr size_t MiB = 1u << 20, KiB = 1u << 10;
constexpr size_t WS_CTL = 0, CTL_ZERO_BYTES = 2 * MiB;
constexpr size_t WS_SELM = 1 * MiB;
constexpr size_t WS_CV = 3 * MiB;
constexpr size_t CV_C1IN = 0, CV_C2IN = 4 * 2816, CV_C1UP = 8 * 2816, CV_C2UP = 8 * 2816 + 4 * 4096;
constexpr size_t WS_ROPE = 4 * MiB;
constexpr size_t WS_BIAS1 = 4 * MiB + 128 * KiB;
constexpr size_t WS_W2G = 4 * MiB + 192 * KiB;
constexpr size_t WS_WP = 4 * MiB + 256 * KiB;
constexpr size_t WS_W2C = 4 * MiB + 384 * KiB;
constexpr size_t WS_GB = 4 * MiB + 448 * KiB;
constexpr size_t WS_W1C = 5 * MiB;
constexpr size_t WS_WIN = 7 * MiB;
constexpr size_t WS_WOUT = 29 * MiB;
constexpr size_t WS_WUP = 37 * MiB;
constexpr size_t WS_WDN = 69 * MiB;
constexpr size_t WS_KC = 101 * MiB;
constexpr size_t WS_VC = 101 * MiB + 512 * KiB;
constexpr size_t WS_DECAY = 102 * MiB;
constexpr size_t WS_DST = 103 * MiB;
constexpr size_t WS_XN = 127 * MiB;
constexpr size_t WS_R = 191 * MiB;
constexpr size_t WS_MIXED = WS_R + 22 * MiB, SLAB_PADP = 10 * MiB, SLAB_PADM = 24 * MiB;
constexpr size_t WS_ST = 447 * MiB;
constexpr size_t WS_VT = 455 * MiB;
constexpr size_t WS_QK = 471 * MiB;
constexpr size_t WS_CP = 495 * MiB;
constexpr size_t CP_UP = (size_t)3 * 2 * 16 * 2816;
constexpr size_t WS_END = 499 * MiB;
static_assert(WS_CV + (8 * 2816 + 8 * 4096) * 4 <= WS_ROPE && WS_WIN + (size_t)DEPTH * NPROJ * D * 2 <= WS_WOUT && WS_DST + (size_t)16 * 6 * 32 * 32 * 64 * 4 <= WS_XN && (size_t)4096 * NPROJ * 2 <= 22 * MiB && (size_t)4096 * D * 2 <= 8 * MiB && (size_t)4096 * FF * 2 == 32 * MiB && WS_R + 8 * 32 * MiB <= WS_ST && WS_ST + (size_t)2 * T * 32 * 4 <= WS_VT && WS_VT + (size_t)16 * 2 * 2 * 64 * 2048 * 2 <= WS_QK && WS_QK + (size_t)T * 384 * 2 <= WS_CP && WS_CP + (CP_UP + (size_t)4 * 2 * 16 * 4096) * 4 <= WS_END, "d_ws map");
constexpr int CW_SELF = 16384;
constexpr int CW_BAR = 4096;

constexpr int SCR_BYTES = 143360;
constexpr int LDSCTL_OFF = SCR_BYTES;
constexpr int LDS_BYTES = 147456;

#define GAS __attribute__((address_space(1)))
#define LAS __attribute__((address_space(3)))
typedef unsigned short bf16;
typedef unsigned v4u __attribute__((ext_vector_type(4)));
typedef unsigned v2u __attribute__((ext_vector_type(2)));
typedef float f32x4 __attribute__((ext_vector_type(4)));
typedef float f32x16 __attribute__((ext_vector_type(16)));
typedef short bf16x8 __attribute__((ext_vector_type(8)));
#define LDS_WAIT() asm volatile("s_waitcnt lgkmcnt(0)" ::: "memory")
#define VM_WAIT() asm volatile("s_waitcnt vmcnt(0)" ::: "memory")
typedef float f32x2_t __attribute__((ext_vector_type(2))); typedef __bf16 bf16x2_t __attribute__((ext_vector_type(2)));
__device__ __forceinline__ unsigned pk2(float lo, float hi) { const f32x2_t v = {lo, hi}; const bf16x2_t b = __builtin_convertvector(v, bf16x2_t); return __builtin_bit_cast(unsigned, b); }
__device__ __forceinline__ unsigned f2bf(float f) { return pk2(f, 0.f) & 0xffffu; }
__device__ __forceinline__ float bf2f(unsigned b) { return __builtin_bit_cast(float, b << 16); }
__device__ __forceinline__ float bflo(unsigned w) { return __builtin_bit_cast(float, w << 16); }
__device__ __forceinline__ float bfhi(unsigned w) { return __builtin_bit_cast(float, w & 0xffff0000u); }
__device__ __forceinline__ f32x4 mma16(bf16x8 a, bf16x8 b, f32x4 c) { return __builtin_amdgcn_mfma_f32_16x16x32_bf16(a, b, c, 0, 0, 0); }
__device__ __forceinline__ f32x16 mma32(bf16x8 a, bf16x8 b, f32x16 c) { return __builtin_amdgcn_mfma_f32_32x32x16_bf16(a, b, c, 0, 0, 0); }
__device__ __forceinline__ float ex2(float x) { return __builtin_amdgcn_exp2f(x); }
__device__ __forceinline__ float fexp(float x) { return __builtin_amdgcn_exp2f(x * 1.4426950408889634f); }
__device__ __forceinline__ float sigmoidf_(float x) { return __builtin_amdgcn_rcpf(1.0f + fexp(-x)); }
__device__ __forceinline__ bf16x8 as_bf16x8(v4u v) { return __builtin_bit_cast(bf16x8, v); }
#define XB_TMO      128
#define XB_XCNT(j)  (256  + 64 * (j))
#define XB_XSUB(j)  (1280 + 64 * (j))
#define XB_XGEN(j)  (2304 + 64 * (j))
#define XB_TOP      3328
#define XB_TOPGEN   3392
#define XB_LSUB(j)  (3456 + 64 * (j))
#define XB_LGEN(j)  (4480 + 64 * (j))
#define XCD_BAR_WORDS 5504
#define XB_SPIN_CAP (1u << 18)

__device__ __forceinline__ unsigned xb_ld(unsigned* p)              { return __hip_atomic_load(p, __ATOMIC_RELAXED, __HIP_MEMORY_SCOPE_AGENT); }
__device__ __forceinline__ unsigned xb_add(unsigned* p, unsigned v) { return __hip_atomic_fetch_add(p, v, __ATOMIC_RELAXED, __HIP_MEMORY_SCOPE_AGENT); }
__device__ __forceinline__ unsigned xb_xcc_id() { return (unsigned)__builtin_amdgcn_s_getreg((3 << 11) | 20) & 0xFu; }
#define XB_SPIN(cond, bar) do { unsigned _sp = 0; while (cond) { __builtin_amdgcn_s_sleep(1); \
    if ((++_sp & 255u) == 0u) { if (xb_ld(&(bar)[XB_TMO])) break; if (_sp > XB_SPIN_CAP) { atomicAdd(&(bar)[XB_TMO], 1u); break; } } } } while (0)

struct XcdBarrier {
    unsigned* bar; unsigned x;
    volatile LAS unsigned* st;
};

__device__ __forceinline__ XcdBarrier xcd_barrier_post(unsigned* bar, volatile LAS unsigned* st) {
    XcdBarrier b; b.bar = bar; b.x = xb_xcc_id(); b.st = st;
    if (threadIdx.x == 0) st[2] = xb_add(&bar[XB_XCNT(b.x)], 1u);
    return b;
}
__device__ __forceinline__ void xcd_barrier_complete(unsigned* bar, unsigned x, unsigned& nloc, unsigned& nx) {
    const unsigned G = gridDim.x * gridDim.y * gridDim.z;
    unsigned sum, cnt, mine, sp = 0u;
    for (;;) {
        sum = 0u; cnt = 0u; mine = 0u;
#pragma unroll
        for (unsigned j = 0; j < 16; ++j) { const unsigned c = xb_ld(&bar[XB_XCNT(j)]); sum += c; cnt += (c > 0u) ? 1u : 0u; mine = (j == x) ? c : mine; }
        if (sum == G) break;
        __builtin_amdgcn_s_sleep(1);
        if ((++sp & 255u) == 0u) { if (xb_ld(&bar[XB_TMO])) break; if (sp > XB_SPIN_CAP) { atomicAdd(&bar[XB_TMO], 1u); break; } }
    }
    nloc = mine > 0u ? mine : 1u; nx = cnt > 0u ? cnt : 1u;
}

__device__ __forceinline__ void xcd_barrier(const XcdBarrier& b, const bool leader_thread  ) {
    asm volatile("s_waitcnt vmcnt(0)" ::: "memory");
    __syncthreads();
    if (leader_thread) {
        unsigned* bar = b.bar;
        __builtin_amdgcn_s_waitcnt(0);
        unsigned nloc = b.st[0], nx = b.st[1];
        if (nloc == 0u) { xcd_barrier_complete(bar, b.x, nloc, nx); b.st[0] = nloc; b.st[1] = nx; }
        const unsigned old = xb_add(&bar[XB_XSUB(b.x)], 1u);
        const unsigned gen = old / nloc;
        if (old + 1u == (gen + 1u) * nloc) {
            __builtin_amdgcn_fence(__ATOMIC_RELEASE, "agent");
            asm volatile("s_waitcnt vmcnt(0)" ::: "memory");
            const unsigned og = xb_add(&bar[XB_TOP], 1u);
            const unsigned tg = og / nx;
            if (og + 1u == (tg + 1u) * nx) xb_add(&bar[XB_TOPGEN], 1u);
            else XB_SPIN(xb_ld(&bar[XB_TOPGEN]) == tg, bar);
            __builtin_amdgcn_fence(__ATOMIC_ACQUIRE, "agent");
            xb_add(&bar[XB_XGEN(b.x)], 1u);
            asm volatile("s_waitcnt vmcnt(0)" ::: "memory");
        } else {
            XB_SPIN(xb_ld(&bar[XB_XGEN(b.x)]) == gen, bar);
            __builtin_amdgcn_fence(__ATOMIC_ACQUIRE, "agent");
            asm volatile("s_waitcnt vmcnt(0)" ::: "memory");
        }
    }
    __syncthreads();
}

__device__ __forceinline__ void xcd_barrier_local(const XcdBarrier& b, const bool leader_thread) {
    asm volatile("s_waitcnt vmcnt(0)" ::: "memory");
    __syncthreads();
    if (leader_thread) {
        unsigned* bar = b.bar;
        __builtin_amdgcn_s_waitcnt(0);
        const unsigned nloc = b.st[0];
        const unsigned old = xb_add(&bar[XB_LSUB(b.x)], 1u);
        const unsigned target = (old / nloc + 1u) * nloc;
        if (old + 1u != target) XB_SPIN(xb_ld(&bar[XB_LSUB(b.x)]) < target, bar);
        __builtin_amdgcn_fence(__ATOMIC_ACQUIRE, "agent");
        asm volatile("s_waitcnt vmcnt(0)" ::: "memory");
    }
    __syncthreads();
}
__device__ __forceinline__ int xcd_local_id(const XcdBarrier& b, unsigned G) {
    unsigned nx = 0u, xidx = 0u; bool even = (G == 256u);
#pragma unroll
    for (unsigned j = 0; j < 16; ++j) { const unsigned c = xb_ld(&b.bar[XB_XCNT(j)]); if (c) { if (c != 32u) even = false; if (j < b.x) ++xidx; ++nx; } }
    const unsigned rank = b.st[2];
    return (even && nx == 8u && rank < 32u) ? (int)(rank * 8u + xidx) : -1;
}

struct Frame { LAS unsigned char* lds; int tid, lane, wave, G, bid, wave0, cid, lok; };
#define FRAME_REFRESH(F) do { int w_ = (F).wave0; asm volatile("" : "+s"(w_)); unsigned m_ = ~0u; asm volatile("" : "+s"(m_)); int l_ = (int)__builtin_amdgcn_mbcnt_hi(m_, __builtin_amdgcn_mbcnt_lo(m_, 0u)); asm volatile("" : "+v"(l_)); int b_ = (F).cid; asm volatile("" : "+s"(b_)); (F).tid = w_ * 64 + l_; (F).lane = l_; (F).wave = w_; (F).bid = b_; } while (0)
struct Args { const float* in[17]; float* out; unsigned char* ws; int ph_lo, ph_hi; };
static_assert(sizeof(Args) == 19 * 8 + 8, "Args has no padding");
__device__ __forceinline__ const unsigned char* karg_ptr(int idx) {
    unsigned long long base = (unsigned long long)__builtin_amdgcn_kernarg_segment_ptr();
    asm volatile("" : "+s"(base));
    const unsigned long long v = ((const __attribute__((address_space(4))) unsigned long long*)base)[idx];
    return (const unsigned char*)(const __attribute__((address_space(1))) unsigned char*)v;
}
#define P_IN_(i) ((const float*)karg_ptr(i))
#define P_x P_IN_(0)
#define P_w_in P_IN_(1)
#define P_cmp_pos P_IN_(2)
#define P_cmp_w1 P_IN_(3)
#define P_cmp_w2 P_IN_(4)
#define P_gla_w2 P_IN_(5)
#define P_gla_b P_IN_(6)
#define P_gla_ng P_IN_(7)
#define P_pool_w P_IN_(8)
#define P_pool_s P_IN_(9)
#define P_w_out P_IN_(10)
#define P_ln1_g P_IN_(11)
#define P_ln1_b P_IN_(12)
#define P_w_up P_IN_(13)
#define P_w_down P_IN_(14)
#define P_ln2_g P_IN_(15)
#define P_ln2_b P_IN_(16)
#define P_H ((float*)karg_ptr(17))
#define P_WS ((unsigned char*)karg_ptr(18))
#define P_rope ((float*)(P_WS + WS_ROPE))
#define P_bias1 ((float*)(P_WS + WS_BIAS1))
#define P_decay ((float*)(P_WS + WS_DECAY))
#define P_dst ((float*)(P_WS + WS_DST))
#define P_W2G ((bf16*)(P_WS + WS_W2G))
#define P_WP ((bf16*)(P_WS + WS_WP))
#define P_W2C ((bf16*)(P_WS + WS_W2C))
#define P_W1C ((bf16*)(P_WS + WS_W1C))
#define P_WIN ((bf16*)(P_WS + WS_WIN))
#define P_WOUT ((bf16*)(P_WS + WS_WOUT))
#define P_WUP ((bf16*)(P_WS + WS_WUP))
#define P_WDN ((bf16*)(P_WS + WS_WDN))
#define P_KC ((bf16*)(P_WS + WS_KC))
#define P_SELM(l) ((unsigned*)(P_WS + WS_SELM) + (size_t)(l) * 32 * SEQ)
#define P_VC ((bf16*)(P_WS + WS_VC))
#define P_XN ((bf16*)(P_WS + WS_XN))
#define P_VT ((bf16*)(P_WS + WS_VT))
#define P_QK ((bf16*)(P_WS + WS_QK))
#define P_CP ((float*)(P_WS + WS_CP))
#define P_PROJ ((bf16*)(P_WS + WS_R))
#define P_MIXED ((bf16*)(P_WS + WS_MIXED))
#define P_U ((bf16*)(P_WS + WS_R))
#define P_PROJ_B(b) ((bf16*)(P_WS + WS_R + (size_t)((b) >> 1) * SLAB_PADP))
#define P_MIXED_B(b) ((bf16*)(P_WS + WS_MIXED + (size_t)((b) >> 1) * SLAB_PADM))
#define P_ST(k) ((float*)(P_WS + WS_ST) + (size_t)((k) & 1) * T * 8)
#define P_CV ((float*)(P_WS + WS_CV))
#define P_GB ((float*)(P_WS + WS_GB))
__device__ __forceinline__ float wave_sum(float v, int lane) {
#pragma unroll
    for (int o = 1; o < 64; o <<= 1) v += shx(v, o, lane);
    return v;
}

__device__ __forceinline__ int inproj_src_col(int n) {
    if (n < 1152) return n;
    if (n < 1920) return n + 18;
    if (n < 2560) return n + 34;
    if (n < 2576) return 1938 + (n - 2560);
    if (n < 2594) return 1152 + (n - 2576);
    return -1;
}
template <bool MAPIN, bool FOLD>
__device__ __forceinline__ void transpose_item(const float* W, int K, int Nsrc, bf16* WT, LAS float* scr, int kb, int nb, int lane, const float* gam = nullptr, const float* bet = nullptr, float* cp1 = nullptr, float* cp2 = nullptr) {
    typedef float f32x2t __attribute__((ext_vector_type(2)));
    const int k0 = 64 * kb, n0 = 64 * nb, cp = lane & 31, kh = lane >> 5;
    int sc = n0 + 2 * cp; if (MAPIN) sc = inproj_src_col(sc);
    f32x2t a1 = (f32x2t){0.f, 0.f}, a2 = a1;
#pragma unroll 1
    for (int hb = 0; hb < 2; ++hb) {
        f32x2t wv[16]; float gg[FOLD ? 16 : 1], bb[FOLD ? 16 : 1];
#pragma unroll
        for (int i = 0; i < 16; ++i) { const int kk = 2 * (16 * hb + i) + kh; wv[i] = (f32x2t){0.f, 0.f};
            if (sc >= 0) wv[i] = *(const f32x2t*)(W + (size_t)(k0 + kk) * Nsrc + sc);
            if (FOLD) { gg[i] = gam[k0 + kk]; bb[i] = bet[k0 + kk]; } }
#pragma unroll
        for (int i = 0; i < 16; ++i) { const int kk = 2 * (16 * hb + i) + kh; f32x2t w = wv[i];
            if (FOLD) { a2 = a2 + w * bb[i]; w = w * gg[i]; a1[0] += bf2f(f2bf(w[0])); a1[1] += bf2f(f2bf(w[1])); }
            scr[kk * 65 + 2 * cp] = w[0]; scr[kk * 65 + 2 * cp + 1] = w[1]; }
    }
    if (FOLD) { a1[0] += shx(a1[0], 32, lane); a1[1] += shx(a1[1], 32, lane); a2[0] += shx(a2[0], 32, lane); a2[1] += shx(a2[1], 32, lane);
        if (kh == 0) { *(f32x2t*)(cp1 + n0 + 2 * cp) = a1; *(f32x2t*)(cp2 + n0 + 2 * cp) = a2; } }
    LDS_WAIT(); asm volatile("" ::: "memory");
    const int c = lane & 7;
#pragma unroll
    for (int j = 0; j < 8; ++j) { const int n = (lane >> 3) + 8 * j; const LAS float* s = scr + (8 * c) * 65 + n;
        v4u o; o.x = pk2(s[0 * 65], s[1 * 65]); o.y = pk2(s[2 * 65], s[3 * 65]); o.z = pk2(s[4 * 65], s[5 * 65]); o.w = pk2(s[6 * 65], s[7 * 65]);
        *(v4u*)(WT + (size_t)(n0 + n) * K + k0 + 8 * c) = o; }
    LDS_WAIT(); asm volatile("" ::: "memory");
}

__device__ __forceinline__ void p0_prologue(Frame& F) {
    LAS float* scr = (LAS float*)(F.lds + F.wave * 16640);
    const int gw = F.bid * NWAVES + F.wave, NGW = F.G * NWAVES;
    constexpr int I_IN = (D / 64) * (NPROJ / 64), I_OUT = (D / 64) * (D / 64), I_UP = (D / 64) * (FF / 64), I_DN = (FF / 64) * (D / 64), I_C1 = 2 * 32, I_C2 = 2, I_WP = 4;
    constexpr int I_LAYER = I_IN + I_OUT + I_UP + I_DN + I_C1 + I_C2 + I_WP;
    for (int it = gw; it < DEPTH * I_LAYER; it += NGW) {
        const int l = it / I_LAYER; int r = it % I_LAYER;
        if (r < I_IN) { if (l == 0) transpose_item<true, false>(P_w_in, D, P_IN, P_WIN, scr, r / (NPROJ / 64), r % (NPROJ / 64), F.lane);
                         else transpose_item<true, true>(P_w_in + (size_t)l * D * P_IN, D, P_IN, P_WIN + (size_t)l * NPROJ * D, scr, r / (NPROJ / 64), r % (NPROJ / 64), F.lane, P_ln2_g + (l - 1) * D, P_ln2_b + (l - 1) * D,
                                                        P_CP + ((size_t)((l - 1) * 2 + 0) * 16 + r / (NPROJ / 64)) * NPROJ, P_CP + ((size_t)((l - 1) * 2 + 1) * 16 + r / (NPROJ / 64)) * NPROJ);
                         continue; } r -= I_IN;
        if (r < I_OUT) { transpose_item<false, false>(P_w_out + (size_t)l * D * D, D, D, P_WOUT + (size_t)l * D * D, scr, r / (D / 64), r % (D / 64), F.lane); continue; } r -= I_OUT;
        if (r < I_UP) { transpose_item<false, true>(P_w_up + (size_t)l * D * FF, D, FF, P_WUP + (size_t)l * D * FF, scr, r / (FF / 64), r % (FF / 64), F.lane, P_ln1_g + l * D, P_ln1_b + l * D,
                                                      P_CP + CP_UP + ((size_t)(l * 2 + 0) * 16 + r / (FF / 64)) * FF, P_CP + CP_UP + ((size_t)(l * 2 + 1) * 16 + r / (FF / 64)) * FF); continue; } r -= I_UP;
        if (r < I_DN) { transpose_item<false, false>(P_w_down + (size_t)l * D * FF, FF, D, P_WDN + (size_t)l * D * FF, scr, r / (D / 64), r % (D / 64), F.lane); continue; } r -= I_DN;
        if (r < I_C1) { const int kv = r / 32, rr = r % 32; transpose_item<false, false>(P_cmp_w1 + (size_t)(l * 2 + kv) * 2048 * 64, 2048, 64, P_W1C + (size_t)(l * 2 + kv) * 64 * 2048, scr, rr, 0, F.lane); continue; } r -= I_C1;
        if (r < I_C2) { const int kv = r; transpose_item<false, false>(P_cmp_w2 + (size_t)(l * 2 + kv) * 64 * 64, 64, 64, P_W2C + (size_t)(l * 2 + kv) * 64 * 64, scr, 0, 0, F.lane); continue; } r -= I_C2;
        { const int g = r; transpose_item<false, false>(P_pool_w + (size_t)(l * 4 + g) * 64 * 64, 64, 64, P_WP + (size_t)(l * 4 + g) * 64 * 64, scr, 0, 0, F.lane); }
    }
    for (int task = F.bid + F.G * F.wave; task < DEPTH * 2 * 64; task += NGW) {
        const int lk = task >> 6, j = task & 63; const float* pp = P_cmp_pos + (size_t)lk * 2048; const float* ww = P_cmp_w1 + (size_t)lk * 2048 * 64 + j;
        float s = 0.f;
#pragma unroll 1
        for (int k0 = F.lane; k0 < 2048; k0 += 512) { float pv[8], wv[8];
#pragma unroll
            for (int i = 0; i < 8; ++i) { pv[i] = pp[k0 + 64 * i]; wv[i] = ww[(size_t)(k0 + 64 * i) * 64]; }
#pragma unroll
            for (int i = 0; i < 8; ++i) s += pv[i] * wv[i]; }
        s = wave_sum(s, F.lane);
        if (F.lane == 0) P_bias1[task] = s;
    }
    const int gt = F.bid * (NWAVES * 64) + F.tid, NGT = F.G * NWAVES * 64;
    float* const ropep = P_rope;
    for (int idx = gt; idx < SEQ * 8; idx += NGT) {
        const int pos = idx >> 3, i = idx & 7;
        const float inv = (i == 0) ? 1.0f : (i == 1) ? 0.1939227432012558f : (i == 2) ? 0.03760603070259094f : (i == 3) ? 0.007292664609849453f : (i == 4) ? 0.0014142135623842478f
                        : (i == 5) ? 0.00027424818836152554f : (i == 6) ? 5.318296098266728e-05f : 1.0313386155758053e-05f;
        const float ang = (float)pos * inv;
        double rev = (double)ang * 0.15915494309189535; rev -= __builtin_floor(rev);
        const float rf = (float)rev;
        ropep[pos * 16 + i] = __builtin_amdgcn_cosf(rf); ropep[pos * 16 + 8 + i] = __builtin_amdgcn_sinf(rf);
    }
    for (int idx = gt; idx < 8 * 2048; idx += NGT) { const int k = idx >> 11, c = idx & 1023, isb = (idx >> 10) & 1, l = k >> 1;
        const float* src = (k & 1) ? (isb ? P_ln2_b : P_ln2_g) : (isb ? P_ln1_b : P_ln1_g); P_GB[idx] = src[l * D + c]; }
    { bf16* const w2g = P_W2G; const float* const gw2 = P_gla_w2;
    for (int idx = gt; idx < DEPTH * 192 * 32; idx += NGT) {
        const int k = idx & 31, col = (idx >> 5) % 192, l = idx / (192 * 32);
        w2g[idx] = (k < 16) ? (bf16)f2bf(gw2[(size_t)(l * 16 + k) * 192 + col]) : (bf16)0;
    } }
    { const float* const xin = P_x; bf16* const xn = P_XN;
    const size_t step = (size_t)NGT * 8;
    for (size_t i = (size_t)gt * 8; i < (size_t)T * D; i += 4 * step) {
        f32x4 a[4], b[4];
#pragma unroll
        for (int k = 0; k < 4; ++k) if (i + k * step < (size_t)T * D) { a[k] = *(const f32x4*)(xin + i + k * step); b[k] = *(const f32x4*)(xin + i + k * step + 4); }
#pragma unroll
        for (int k = 0; k < 4; ++k) if (i + k * step < (size_t)T * D) { v4u o; o.x = pk2(a[k][0], a[k][1]); o.y = pk2(a[k][2], a[k][3]); o.z = pk2(b[k][0], b[k][1]); o.w = pk2(b[k][2], b[k][3]);
            *(v4u*)(xn + i + k * step) = o; }
    } }
}

__device__ __forceinline__ void fold_vectors_reduce(Frame& F) {
    const float* const cpb = P_CP; float* const cv = P_CV;
    const int gt = F.bid * (NWAVES * 64) + F.tid, NGT = F.G * NWAVES * 64;
    constexpr int N_IN = 3 * 2 * NPROJ, N_UP = 4 * 2 * FF;
    for (int idx = gt; idx < N_IN + N_UP; idx += NGT) {
        const bool isup = idx >= N_IN; const int e = isup ? idx - N_IN : idx, N = isup ? FF : NPROJ;
        const int lw = e / N, n = e % N, which = lw & 1, l = isup ? (lw >> 1) : 1 + (lw >> 1);
        const float* p = cpb + (isup ? CP_UP : 0) + (size_t)lw * 16 * N + n;
        float s = 0.f;
#pragma unroll
        for (int kb = 0; kb < 16; ++kb) s += p[(size_t)kb * N];
        cv[(isup ? (which ? CV_C2UP : CV_C1UP) + (size_t)l * FF : (which ? CV_C2IN : CV_C1IN) + (size_t)l * NPROJ) + n] = s;
    }
}
__device__ __forceinline__ void final_ln_phase(Frame& F, const float* st, const float* gam, const float* bet) {
    float* const Hp = P_H; const bf16* const XNp = P_XN;
    const int gw = F.bid * NWAVES + F.wave, NGW = F.G * NWAVES;
    f32x4 gv[4], bv[4];
#pragma unroll
    for (int j = 0; j < 4; ++j) { gv[j] = *(const f32x4*)(gam + 4 * F.lane + 256 * j); bv[j] = *(const f32x4*)(bet + 4 * F.lane + 256 * j); }
    v2u w[4], wn[4]; float sv, svn;
#define FLN_REQ(m_, W_, S_) do { const bf16* xr_ = XNp + (size_t)(m_) * D + 4 * F.lane; S_ = (F.lane < 8) ? st[(size_t)(m_) * 8 + F.lane] : 0.f; \
        _Pragma("unroll") for (int j = 0; j < 4; ++j) W_[j] = *(const v2u*)(xr_ + 256 * j); } while (0)
    if (gw < T) FLN_REQ(gw, w, sv);
    for (int m = gw; m < T; m += NGW) {
        const bool more = m + NGW < T;
        if (more) FLN_REQ(m + NGW, wn, svn);
        float* hr = Hp + (size_t)m * D + 4 * F.lane;
        sv += shx(sv, 2, F.lane); sv += shx(sv, 4, F.lane);
        const float s0 = __builtin_bit_cast(float, __builtin_amdgcn_readlane(__builtin_bit_cast(int, sv), 0)), s1 = __builtin_bit_cast(float, __builtin_amdgcn_readlane(__builtin_bit_cast(int, sv), 1));
        const float mu = s0 * (1.0f / 1024.0f), rstd = 1.0f / sqrtf(fmaxf(s1 * (1.0f / 1024.0f) - mu * mu, 0.f) + LN_EPS);
#pragma unroll
        for (int j = 0; j < 4; ++j) { f32x4 v; v[0] = bflo(w[j].x); v[1] = bfhi(w[j].x); v[2] = bflo(w[j].y); v[3] = bfhi(w[j].y); *(f32x4*)(hr + 256 * j) = (v - mu) * rstd * gv[j] + bv[j]; }
        if (more) { sv = svn;
#pragma unroll
            for (int j = 0; j < 4; ++j) w[j] = wn[j]; }
    }
#undef FLN_REQ
}

__device__ __forceinline__ void m1_compress(Frame& F, int l, int unit) {
    const bf16* const W1C = P_W1C; const bf16* const W2C = P_W2C; const float* const bias1 = P_bias1; bf16* const KC = P_KC; bf16* const VC = P_VC;
    const int rb = unit & 3, kv = (unit >> 2) & 1, g = (unit >> 3) & 1, b = unit >> 4;
    const bf16* const PROJ = P_PROJ_B(b);
    LAS bf16* Ts = (LAS bf16*)F.lds;
    LAS bf16* Hs = Ts + 528 * 72;
    const int colsrc = C_KV + ((0 * 2 + kv) * 2 + g) * 64, tok0 = 512 * rb;
    for (int c = F.tid; c < 528 * 8; c += NWAVES * 64) {
        const int r = c >> 3, ch = c & 7, tok = tok0 + r; v4u v = (v4u){0u, 0u, 0u, 0u};
        if (tok < SEQ) v = *(const v4u*)(PROJ + (size_t)(b * SEQ + tok) * NPROJ + colsrc + 8 * ch);
        *(LAS v4u*)(Ts + r * 72 + 8 * ch) = v;
    }
    __syncthreads();
    const int mt = F.wave >> 2, nt = F.wave & 3, fr = F.lane & 15, fq = F.lane >> 4;
    const int lk = l * 2 + kv;
    {
        const bf16* w1t = W1C + ((size_t)lk * 64 + 16 * nt + fr) * 2048 + 8 * fq;
        const LAS bf16* ap = Ts + (16 * (16 * mt + fr)) * 72;
        f32x4 acc = (f32x4){0.f, 0.f, 0.f, 0.f};
#pragma unroll 8
        for (int kk = 0; kk < 64; ++kk) { const int k0 = 32 * kk + 8 * fq;
            const bf16x8 a = *(const LAS bf16x8*)(ap + (k0 >> 6) * 72 + (k0 & 63));
            const bf16x8 w = *(const bf16x8*)(w1t + 32 * kk);
            acc = mma16(a, w, acc); }
        const float bias = bias1[lk * 64 + 16 * nt + fr];
#pragma unroll
        for (int r = 0; r < 4; ++r) { const float xv = acc[r] + bias;
            const float u = 0.7978845608028654f * (xv + 0.044715f * xv * xv * xv);
            const float th = 1.0f - 2.0f * __builtin_amdgcn_rcpf(1.0f + fexp(2.0f * u));
            const float gl = 0.5f * xv * (1.0f + th);
            Hs[(16 * mt + 4 * fq + r) * 72 + 16 * nt + fr] = (bf16)f2bf(gl); }
    }
    __syncthreads();
    {
        const bf16* w2t = W2C + ((size_t)lk * 64 + 16 * nt + fr) * 64 + 8 * fq;
        f32x4 acc = (f32x4){0.f, 0.f, 0.f, 0.f};
#pragma unroll
        for (int kk = 0; kk < 2; ++kk) { const bf16x8 a = *(const LAS bf16x8*)(Hs + (16 * mt + fr) * 72 + 32 * kk + 8 * fq); const bf16x8 w = *(const bf16x8*)(w2t + 32 * kk); acc = mma16(a, w, acc); }
        const int n0 = 32 * rb + 16 * mt + 4 * fq;
        if (kv == 0) { bf16* dstp = KC + (size_t)(b * 2 + g) * 128 * 64;
#pragma unroll
            for (int r = 0; r < 4; ++r) dstp[(n0 + r) * 64 + 16 * nt + fr] = (n0 + r < 127) ? (bf16)f2bf(acc[r]) : (bf16)0;
        } else {
            v2u w; w.x = pk2(acc[0], acc[1]); w.y = pk2(acc[2], (n0 + 3 < 127) ? acc[3] : 0.f);
            *(v2u*)(VC + ((size_t)(b * 2 + g) * 64 + 16 * nt + fr) * 128 + n0) = w; }
    }
    __syncthreads();
}

__device__ __forceinline__ void m1_vt(Frame& F, int unit) {
    bf16* const VT = P_VT;
    const int chunk = unit & 7, g = (unit >> 3) & 1, brm = (unit >> 4) & 1, b = unit >> 5;
    const bf16* const PROJ = P_PROJ_B(b);
    LAS bf16* Ls = (LAS bf16*)F.lds;
    const int colV = C_KV + (((1 + brm) * 2 + 1) * 2 + g) * 64;
#pragma unroll
    for (int i = 0; i < 4; ++i) { const int idx = F.tid + 512 * i, r = idx >> 3, ch = idx & 7;
        const v4u vv = *(const v4u*)(PROJ + ((size_t)b * SEQ + 256 * chunk + r) * NPROJ + colV + 8 * ch);
        LAS bf16* vp = Ls + (8 * ch) * 264 + ((r + 8 * ch) & 255);
        vp[0 * 264] = (bf16)(vv.x & 0xffffu); vp[1 * 264] = (bf16)(vv.x >> 16); vp[2 * 264] = (bf16)(vv.y & 0xffffu); vp[3 * 264] = (bf16)(vv.y >> 16);
        vp[4 * 264] = (bf16)(vv.z & 0xffffu); vp[5 * 264] = (bf16)(vv.z >> 16); vp[6 * 264] = (bf16)(vv.w & 0xffffu); vp[7 * 264] = (bf16)(vv.w >> 16); }
    __syncthreads();
#pragma unroll
    for (int i = 0; i < 4; ++i) { const int idx = F.tid + 512 * i, d = idx >> 5, c = idx & 31;
        *(v4u*)(VT + ((size_t)((b * 2 + brm) * 2 + g) * 64 + d) * SEQ + 256 * chunk + 8 * c) = *(const LAS v4u*)(Ls + d * 264 + ((8 * c + 8 * (d >> 3)) & 255)); }
    __syncthreads();
}

__device__ __forceinline__ void m1_gla_pool(Frame& F, int l, int unit) {
    bf16* const QK = P_QK; const bf16* const W2G = P_W2G; const float* const gla_b = P_gla_b; float* const decay = P_decay; float* const dst = P_dst; const bf16* const WP = P_WP; const float* const pool_s = P_pool_s;
    const int b = unit >> 5, n = unit & 31; const bf16* const PROJ = P_PROJ_B(b); bf16* const MIXED = P_MIXED_B(b); const size_t row0 = (size_t)b * SEQ + 64 * n;
    const int fr = F.lane & 15, fq = F.lane >> 4;
    LAS float* BC = (LAS float*)F.lds;
    LAS bf16* KeT = (LAS bf16*)(F.lds + 49152);
    LAS bf16* VT = (LAS bf16*)(F.lds + 49152 + 27648);
    v4u qreg[3], kreg[3], vreg[6], ureg[5];
#pragma unroll
    for (int i = 0; i < 3; ++i) { const int idx = F.tid + 512 * i, c = idx / 24, col0 = 8 * (idx % 24);
        qreg[i] = *(const v4u*)(PROJ + (row0 + c) * NPROJ + C_GQ + col0); kreg[i] = *(const v4u*)(PROJ + (row0 + c) * NPROJ + C_GK + col0); }
#pragma unroll
    for (int i = 0; i < 6; ++i) { const int idx = F.tid + 512 * i, c = idx / 48, ch = idx % 48; vreg[i] = *(const v4u*)(PROJ + (row0 + c) * NPROJ + C_GV + 8 * ch); }
#pragma unroll
    for (int i = 0; i < 5; ++i) { const int idx = F.tid + 512 * i, r = idx >> 5, ch = idx & 31, sp = 64 * n + r - 15; ureg[i] = (v4u){0u, 0u, 0u, 0u};
        if (idx < 79 * 32 && sp >= 0) ureg[i] = *(const v4u*)(PROJ + ((size_t)b * SEQ + sp) * NPROJ + C_PU + 8 * ch); }
    __builtin_amdgcn_sched_barrier(0);
#pragma unroll
    for (int hb = 0; hb < 2; ++hb) {
    v4u zav[3], zbv[3]; float zbias[3];
#pragma unroll
    for (int i = 0; i < 3; ++i) { const int id = F.wave + NWAVES * (3 * hb + i), mt = id & 3, nt = id >> 2;
        zav[i] = (v4u){0u, 0u, 0u, 0u};
        if (fq < 2) zav[i] = *(const v4u*)(PROJ + (row0 + 16 * mt + fr) * NPROJ + C_GLR + 8 * fq);
        zbv[i] = *(const v4u*)(W2G + ((size_t)l * 192 + 16 * nt + fr) * 32 + 8 * fq);
        zbias[i] = gla_b[l * 192 + 16 * nt + fr]; }
#pragma unroll
    for (int i = 0; i < 3; ++i) { const int id = F.wave + NWAVES * (3 * hb + i);
        const int mt = id & 3, nt = id >> 2;
        const f32x4 z = mma16(as_bf16x8(zav[i]), as_bf16x8(zbv[i]), (f32x4){0.f, 0.f, 0.f, 0.f});
        const float bias = zbias[i];
#pragma unroll
        for (int r = 0; r < 4; ++r) { const float zz = z[r] + bias;
            const float ls = fminf(zz, 0.f) - __logf(1.0f + fexp(-fabsf(zz)));
            BC[(16 * mt + 4 * fq + r) * 192 + 16 * nt + fr] = ls * (1.0f / 16.0f); }
    }
    }
#pragma unroll
    for (int i = 0; i < 6; ++i) { const int idx = F.tid + 512 * i, c = idx / 48, ch = idx % 48; const v4u vv = vreg[i];
        LAS bf16* vp = VT + (8 * ch) * 72 + ((c + 8 * (ch & 7)) & 63);
        vp[0 * 72] = (bf16)(vv.x & 0xffffu); vp[1 * 72] = (bf16)(vv.x >> 16); vp[2 * 72] = (bf16)(vv.y & 0xffffu); vp[3 * 72] = (bf16)(vv.y >> 16);
        vp[4 * 72] = (bf16)(vv.z & 0xffffu); vp[5 * 72] = (bf16)(vv.z >> 16); vp[6 * 72] = (bf16)(vv.w & 0xffffu); vp[7 * 72] = (bf16)(vv.w >> 16); }
    __syncthreads();
    if (F.tid < 192) { float run = 0.f;
#pragma unroll 8
        for (int c = 0; c < 64; ++c) { run += BC[c * 192 + F.tid]; BC[c * 192 + F.tid] = run; } }
    __syncthreads();
#pragma unroll
    for (int i = 0; i < 3; ++i) { const int idx = F.tid + 512 * i, c = idx / 24, col0 = 8 * (idx % 24);
        const v4u qv = qreg[i], kvv = kreg[i];
        float bc[8], bl[8], qf[8], kf[8];
#pragma unroll
        for (int e = 0; e < 8; ++e) { bc[e] = BC[c * 192 + col0 + e]; bl[e] = BC[63 * 192 + col0 + e]; }
        qf[0] = bflo(qv.x); qf[1] = bfhi(qv.x); qf[2] = bflo(qv.y); qf[3] = bfhi(qv.y); qf[4] = bflo(qv.z); qf[5] = bfhi(qv.z); qf[6] = bflo(qv.w); qf[7] = bfhi(qv.w);
        kf[0] = bflo(kvv.x); kf[1] = bfhi(kvv.x); kf[2] = bflo(kvv.y); kf[3] = bfhi(kvv.y); kf[4] = bflo(kvv.z); kf[5] = bfhi(kvv.z); kf[6] = bflo(kvv.w); kf[7] = bfhi(kvv.w);
        float qd[8], ki[8];
#pragma unroll
        for (int e = 0; e < 8; ++e) { qd[e] = qf[e] * 0.17677669529663687f * fexp(bc[e]); ki[e] = kf[e] * fexp(-bc[e]);
            KeT[(col0 + e) * 72 + ((c + col0) & 63)] = (bf16)f2bf(kf[e] * fexp(bl[e] - bc[e])); }
        v4u qo, ko; qo.x = pk2(qd[0], qd[1]); qo.y = pk2(qd[2], qd[3]); qo.z = pk2(qd[4], qd[5]); qo.w = pk2(qd[6], qd[7]);
        ko.x = pk2(ki[0], ki[1]); ko.y = pk2(ki[2], ki[3]); ko.z = pk2(ki[4], ki[5]); ko.w = pk2(ki[6], ki[7]);
        *(v4u*)(QK + (row0 + c) * 384 + col0) = qo; *(v4u*)(QK + (row0 + c) * 384 + 192 + col0) = ko;
    }
    if (F.tid < 192) { const int h = F.tid >> 5, dk = F.tid & 31; decay[(((size_t)b * 6 + h) * 32 + n) * 32 + dk] = fexp(BC[63 * 192 + F.tid]); }
    __syncthreads();
    for (int id = F.wave; id < 48; id += NWAVES) {
        const int h = id >> 3, mt = (id >> 2) & 1, nt = id & 3;
        f32x4 acc = (f32x4){0.f, 0.f, 0.f, 0.f};
#pragma unroll
        for (int kk = 0; kk < 2; ++kk) { const int ra = h * 32 + 16 * mt + fr, rw = h * 64 + 16 * nt + fr;
            const bf16x8 a = *(const LAS bf16x8*)(KeT + ra * 72 + ((32 * kk + 8 * fq + 8 * (ra >> 3)) & 63));
            const bf16x8 w = *(const LAS bf16x8*)(VT + rw * 72 + ((32 * kk + 8 * fq + 8 * (rw >> 3)) & 63)); acc = mma16(w, a, acc); }
        *(f32x4*)(dst + ((((size_t)b * 6 + h) * 32 + n) * 32 + 16 * mt + fr) * 64 + 16 * nt + 4 * fq) = acc;
    }
    __syncthreads();
    LAS bf16* Us = (LAS bf16*)F.lds;
    LAS bf16* Ps = (LAS bf16*)(F.lds + 45056);
#pragma unroll
    for (int i = 0; i < 5; ++i) { const int idx = F.tid + 512 * i, r = idx >> 5, ch = idx & 31; if (idx < 79 * 32) *(LAS v4u*)(Us + r * 264 + 8 * ch) = ureg[i]; }
    __syncthreads();
    {
        const int c = F.tid & 255, th = F.tid >> 8, w = 2 << (c >> 6), t0 = 32 * th;
        float s = 0.f;
        for (int tau = 0; tau < w; ++tau) s += bf2f(Us[(15 + t0 - tau) * 264 + c]);
#pragma unroll 4
        for (int t = t0; t < t0 + 32; ++t) {
            const float ut = bf2f(Us[(15 + t) * 264 + c]);
            if (t > t0) s += ut - bf2f(Us[(15 + t - w) * 264 + c]);
            const int sp = 64 * n + t; const int cnt = (sp + 1 < w) ? sp + 1 : w;
            Ps[t * 264 + c] = (bf16)f2bf(s * __builtin_amdgcn_rcpf((float)cnt) - ut);
        }
    }
    __syncthreads();
    bf16x8 pw[8][2]; f32x4 psc[8];
#pragma unroll
    for (int i = 0; i < 8; ++i) { const int id = F.wave + NWAVES * i, g = id >> 4, nt = id & 3;
        const bf16* wp = WP + ((size_t)(l * 4 + g) * 64 + 16 * nt + fr) * 64 + 8 * fq;
        pw[i][0] = *(const bf16x8*)(wp); pw[i][1] = *(const bf16x8*)(wp + 32); psc[i] = *(const f32x4*)(pool_s + l * 256 + 64 * g + 16 * nt + 4 * fq); }
#pragma unroll
    for (int i = 0; i < 8; ++i) { const int id = F.wave + NWAVES * i;
        const int g = id >> 4, mt = (id >> 2) & 3, nt = id & 3;
        f32x4 acc = (f32x4){0.f, 0.f, 0.f, 0.f};
#pragma unroll
        for (int kk = 0; kk < 2; ++kk) { const bf16x8 a = *(const LAS bf16x8*)(Ps + (16 * mt + fr) * 264 + 64 * g + 32 * kk + 8 * fq); acc = mma16(pw[i][kk], a, acc); }
        acc = acc * psc[i];
        v2u ow; ow.x = pk2(acc[0], acc[1]); ow.y = pk2(acc[2], acc[3]);
        *(v2u*)(MIXED + (row0 + 16 * mt + fr) * D + 768 + 64 * g + 16 * nt + 4 * fq) = ow;
    }
    __syncthreads();
}

__device__ __forceinline__ void m2_gla(Frame& F, int l, int b, int hp) {
    FRAME_REFRESH(F);
    const bf16* const QK = P_QK; const float* const decay = P_decay; const float* const dst = P_dst; const float* const gla_ng = P_gla_ng;
    const bf16* const PROJ = P_PROJ_B(b); bf16* const MIXED = P_MIXED_B(b);
    const int half = F.wave >> 2, cc = F.wave & 3, h = 2 * hp + half, lh = cc * 64 + F.lane, fr = F.lane & 15, fq = F.lane >> 4;
    LAS bf16* Vt = (LAS bf16*)(F.lds + F.wave * 9216);
    LAS bf16* StH = (LAS bf16*)(F.lds + 73728 + half * 20480);
    const int dk = lh >> 3, dv0 = (lh & 7) * 8;
    const int dkr = (dk + 8 * ((lh & 7) & 3)) & 31;
    const unsigned bh = (unsigned)(b * 6 + h);
    f32x4 ngl4[4];
#pragma unroll
    for (int dvt = 0; dvt < 4; ++dvt) ngl4[dvt] = *(const f32x4*)(gla_ng + l * 384 + h * 64 + 16 * dvt + 4 * fq);
    f32x4 S0 = (f32x4){0.f, 0.f, 0.f, 0.f}, S1 = S0;
#pragma unroll 1
    for (int cgrp = 0; cgrp < 8; ++cgrp) {
    const unsigned row0 = (unsigned)(b * SEQ + 64 * (4 * cgrp + cc));
    bf16x8 qf[4], kf[4]; v4u vrow[8]; v2u ogv[4][4];
#pragma unroll
    for (int it = 0; it < 4; ++it) { qf[it] = *(const bf16x8*)(QK + (row0 + 16 * it + fr) * 384u + h * 32 + 8 * fq); kf[it] = *(const bf16x8*)(QK + (row0 + 16 * it + fr) * 384u + 192 + h * 32 + 8 * fq); }
#pragma unroll
    for (int i = 0; i < 8; ++i) vrow[i] = *(const v4u*)(PROJ + (row0 + 8 * i + (F.lane >> 3)) * (unsigned)NPROJ + C_GV + h * 64 + 8 * (F.lane & 7));
#pragma unroll
    for (int it = 0; it < 4; ++it)
#pragma unroll
        for (int dvt = 0; dvt < 4; ++dvt) ogv[it][dvt] = *(const v2u*)(PROJ + (row0 + 16 * it + fr) * (unsigned)NPROJ + C_OG + h * 64 + 16 * dvt + 4 * fq);
    float dcr[4]; f32x4 r0[4], r1[4];
#pragma unroll
    for (int c = 0; c < 4; ++c) { const unsigned j = 4 * cgrp + c; dcr[c] = decay[(bh * 32 + j) * 32 + dk]; const float* dp = dst + ((bh * 32 + j) * 32 + dk) * 64 + dv0; r0[c] = *(const f32x4*)dp; r1[c] = *(const f32x4*)(dp + 4); }
#pragma unroll
    for (int c = 0; c < 4; ++c) { LAS bf16* St = StH + c * 2560;
#pragma unroll
        for (int e = 0; e < 4; ++e) { St[(dv0 + e) * 40 + dkr] = (bf16)f2bf(S0[e]); St[(dv0 + 4 + e) * 40 + dkr] = (bf16)f2bf(S1[e]); }
        S0 = S0 * dcr[c] + r0[c]; S1 = S1 * dcr[c] + r1[c]; }
#pragma unroll
    for (int i = 0; i < 8; ++i) { const v4u w = vrow[i]; LAS bf16* vp = Vt + (8 * (F.lane & 7)) * 72 + ((8 * i + (F.lane >> 3) + 8 * (F.lane & 7)) & 63);
        vp[0 * 72] = (bf16)(w.x & 0xffffu); vp[1 * 72] = (bf16)(w.x >> 16); vp[2 * 72] = (bf16)(w.y & 0xffffu); vp[3 * 72] = (bf16)(w.y >> 16);
        vp[4 * 72] = (bf16)(w.z & 0xffffu); vp[5 * 72] = (bf16)(w.z >> 16); vp[6 * 72] = (bf16)(w.w & 0xffffu); vp[7 * 72] = (bf16)(w.w >> 16); }
    __syncthreads();
    v4u pA[4][2];
#pragma unroll
    for (int it = 0; it < 4; ++it)
#pragma unroll
        for (int jt = 0; jt < 4; ++jt) {
            v2u pk = (v2u){0u, 0u};
            if (jt <= it) { f32x4 a = mma16(kf[jt], qf[it], (f32x4){0.f, 0.f, 0.f, 0.f});
                if (jt == it) {
#pragma unroll
                    for (int r = 0; r < 4; ++r) a[r] = (4 * fq + r <= fr) ? a[r] : 0.f; }
                pk.x = pk2(a[0], a[1]); pk.y = pk2(a[2], a[3]); }
            if (jt & 1) { pA[it][jt >> 1].z = pk.x; pA[it][jt >> 1].w = pk.y; } else { pA[it][jt >> 1].x = pk.x; pA[it][jt >> 1].y = pk.y; }
        }
    const LAS bf16* St = StH + cc * 2560;
    v2u outp[4][4];
#pragma unroll
    for (int it = 0; it < 4; ++it) {
        f32x4 o[4]; float ss = 0.f;
#pragma unroll
        for (int dvt = 0; dvt < 4; ++dvt) {
            f32x4 acc = (f32x4){0.f, 0.f, 0.f, 0.f};
#pragma unroll
            for (int ks = 0; ks < 2; ++ks) if (2 * ks <= it) {
                v4u vf; { const int rot = 8 * (((16 * dvt + fr) >> 3) & 7); const v2u lo = *(const LAS v2u*)(Vt + (16 * dvt + fr) * 72 + ((32 * ks + 4 * fq + rot) & 63)), hi2 = *(const LAS v2u*)(Vt + (16 * dvt + fr) * 72 + ((32 * ks + 16 + 4 * fq + rot) & 63)); vf.x = lo.x; vf.y = lo.y; vf.z = hi2.x; vf.w = hi2.y; }
                acc = mma16(as_bf16x8(vf), as_bf16x8(pA[it][ks]), acc); }
            acc = mma16(*(const LAS bf16x8*)(St + (16 * dvt + fr) * 40 + ((8 * fq + 8 * (((16 * dvt + fr) >> 3) & 3)) & 31)), qf[it], acc);
            o[dvt] = acc; ss += (acc[0] * acc[0] + acc[1] * acc[1]) + (acc[2] * acc[2] + acc[3] * acc[3]); }
        ss += shx(ss, 16, F.lane); ss += shx(ss, 32, F.lane);
        const float rstd = __builtin_amdgcn_rsqf(ss * (1.0f / 64.0f) + RMS_EPS);
#pragma unroll
        for (int dvt = 0; dvt < 4; ++dvt) { const v2u gw = ogv[it][dvt]; const float g0_ = bflo(gw.x), g1_ = bfhi(gw.x), g2_ = bflo(gw.y), g3_ = bfhi(gw.y);
            const f32x4 sc = ngl4[dvt] * rstd;
            outp[it][dvt].x = pk2(o[dvt][0] * sc[0] * (g0_ * sigmoidf_(g0_)), o[dvt][1] * sc[1] * (g1_ * sigmoidf_(g1_)));
            outp[it][dvt].y = pk2(o[dvt][2] * sc[2] * (g2_ * sigmoidf_(g2_)), o[dvt][3] * sc[3] * (g3_ * sigmoidf_(g3_))); }
    }
    asm volatile("s_waitcnt lgkmcnt(0)" ::: "memory");
#pragma unroll
    for (int it = 0; it < 4; ++it)
#pragma unroll
        for (int dvt = 0; dvt < 4; ++dvt) *(LAS v2u*)(Vt + (16 * it + fr) * 72 + 16 * dvt + 4 * fq) = outp[it][dvt];
#pragma unroll
    for (int i2 = 0; i2 < 8; ++i2) { const int r = 8 * i2 + (F.lane >> 3), c = F.lane & 7;
        *(v4u*)(MIXED + (row0 + r) * (unsigned)D + 384 + h * 64 + 8 * c) = *(const LAS v4u*)(Vt + r * 72 + 8 * c); }
    __syncthreads();
    }
}

__device__ __forceinline__ int kperm(int rho) { return (rho & ~12) | ((rho & 4) << 1) | ((rho & 8) >> 1); }
__device__ __forceinline__ bf16x8 pack8(const f32x16& p, int s) {
    v4u w; w.x = pk2(p[8 * s + 0], p[8 * s + 1]); w.y = pk2(p[8 * s + 2], p[8 * s + 3]); w.z = pk2(p[8 * s + 4], p[8 * s + 5]); w.w = pk2(p[8 * s + 6], p[8 * s + 7]);
    return as_bf16x8(w);
}
constexpr float NEG_INF = -__builtin_inff();

template <int BR>
__device__ __forceinline__ void attn_tile(const LAS bf16* Kt, const LAS bf16* Vt, const bf16x8 (&qf)[4], f32x16 (&o)[2], float& mref, float& rmax, float& lsum, int d, int kind, int q, int hi, const f32x16& zero16) {
    f32x16 s[2];
    const int prow = kperm(q);
    {
        bf16x8 kf[2][4];
#pragma unroll
        for (int st = 0; st < 2; ++st)
#pragma unroll
            for (int ds = 0; ds < 4; ++ds) kf[st][ds] = *(const LAS bf16x8*)(Kt + (32 * st + prow) * 72 + 16 * ds + 8 * hi);
        __builtin_amdgcn_sched_barrier(0);
#pragma unroll
        for (int st = 0; st < 2; ++st) {
            s[st] = mma32(kf[st][0], qf[0], zero16);
#pragma unroll
            for (int ds = 1; ds < 4; ++ds) s[st] = mma32(kf[st][ds], qf[ds], s[st]);
        }
    }
    bf16x8 vf0[4];
#pragma unroll
    for (int k = 0; k < 4; ++k) vf0[k] = *(const LAS bf16x8*)(Vt + q * 72 + 16 * k + 8 * hi);
    __builtin_amdgcn_sched_barrier(0);
    if (__any(mref != 0.f)) {
#pragma unroll
        for (int st = 0; st < 2; ++st)
#pragma unroll
            for (int r = 0; r < 16; ++r) asm volatile("v_sub_f32 %0, %0, %1" : "+v"(s[st][r]) : "v"(mref));
    }
    if (kind == 1) {
        const float ninf = NEG_INF;
        if (BR == 0) {
#pragma unroll
            for (int st = 0; st < 2; ++st)
#pragma unroll
                for (int r = 0; r < 16; ++r) asm volatile("v_cmp_gt_i32 vcc, %1, %2\n\ts_nop 1\n\tv_cndmask_b32 %0, %0, %3, vcc" : "+v"(s[st][r]) : "n"(32 * st + 16 * (r >> 3) + (r & 7)), "v"(d), "v"(ninf) : "vcc");
        } else {
#pragma unroll
            for (int st = 0; st < 2; ++st)
#pragma unroll
                for (int r = 0; r < 16; ++r) { unsigned t_; asm volatile("v_subrev_u32 %1, %2, %3\n\tv_cmp_lt_u32 vcc, 511, %1\n\ts_nop 1\n\tv_cndmask_b32 %0, %0, %4, vcc" : "+v"(s[st][r]), "=&v"(t_) : "n"(32 * st + 16 * (r >> 3) + (r & 7)), "v"(d), "v"(ninf) : "vcc"); }
        }
    }
    const bool rowok = (BR == 1) || kind != 2 || d >= 0;
    float mx = NEG_INF;
#pragma unroll
    for (int st = 0; st < 2; ++st)
#pragma unroll
        for (int r = 0; r < 16; ++r) mx = fmaxf(mx, s[st][r]);
    if (BR == 0) mx = rowok ? mx : NEG_INF;
    mx = fmaxf(mx, shx(mx, 32, q + 32 * hi));
    rmax = fmaxf(rmax, mx);
    if (__any(rmax > 8.0f || (rmax < -100.0f && rmax != NEG_INF))) {
        const float delta = (rmax == NEG_INF) ? 0.f : rmax, alpha = ex2(-delta);
        mref += delta; rmax -= delta; lsum *= alpha;
#pragma unroll
        for (int st = 0; st < 2; ++st)
#pragma unroll
            for (int r = 0; r < 16; ++r) { asm volatile("v_mul_f32 %0, %0, %1" : "+v"(o[st][r]) : "v"(alpha)); asm volatile("v_sub_f32 %0, %0, %1" : "+v"(s[st][r]) : "v"(delta)); }
    }
    float ps = 0.f;
#pragma unroll
    for (int st = 0; st < 2; ++st)
#pragma unroll
        for (int r = 0; r < 16; ++r) { const float p = ex2(s[st][r]); s[st][r] = p; ps += p; }
    if (BR == 0) ps = rowok ? ps : 0.f;
    lsum += ps;
    bf16x8 pf[4];
#pragma unroll
    for (int k = 0; k < 4; ++k) { pf[k] = pack8(s[k >> 1], k & 1);
        if (BR == 0) { const unsigned m = rowok ? ~0u : 0u; v4u w = __builtin_bit_cast(v4u, pf[k]); w.x &= m; w.y &= m; w.z &= m; w.w &= m; pf[k] = as_bf16x8(w); } }
    bf16x8 vf1[4];
#pragma unroll
    for (int k = 0; k < 4; ++k) vf1[k] = *(const LAS bf16x8*)(Vt + (32 + q) * 72 + 16 * k + 8 * hi);
#pragma unroll
    for (int k = 0; k < 4; ++k) o[0] = mma32(vf0[k], pf[k], o[0]);
#pragma unroll
    for (int k = 0; k < 4; ++k) o[1] = mma32(vf1[k], pf[k], o[1]);
}
__device__ __forceinline__ void cmp_scores(const LAS bf16* KCs, const bf16x8 (&qf)[4], f32x16 (&s)[4], float& mx, int dc, int prow, int hi, int nst, int nfull) {
    mx = NEG_INF;
#pragma unroll
    for (int st = 0; st < 4; ++st) {
        if (st < nst) {
#pragma unroll
            for (int e = 0; e < 16; ++e) s[st][e] = 0.f;
            bf16x8 kf[4];
#pragma unroll
            for (int ds = 0; ds < 4; ++ds) kf[ds] = *(const LAS bf16x8*)(KCs + (32 * st + prow) * 72 + 16 * ds + 8 * hi);
#pragma unroll
            for (int ds = 0; ds < 4; ++ds) s[st] = mma32(kf[ds], qf[ds], s[st]);
            if (st < nfull) {
#pragma unroll
                for (int r = 0; r < 16; ++r) mx = fmaxf(mx, s[st][r]);
            } else {
#pragma unroll
                for (int r = 0; r < 16; ++r) { const int c16 = 16 * (32 * st + 16 * (r >> 3) + (r & 7)); const float v = (dc >= c16) ? s[st][r] : NEG_INF; s[st][r] = v; mx = fmaxf(mx, v); }
            }
        }
    }
    mx = fmaxf(mx, shx(mx, 32, (prow & ~12) | ((prow & 4) << 1) | ((prow & 8) >> 1) | (hi << 5)));
}
__device__ __forceinline__ void sort16(int (&a)[16]) {
#pragma unroll
    for (int k = 2; k <= 16; k <<= 1)
#pragma unroll
        for (int j = k >> 1; j > 0; j >>= 1)
#pragma unroll
            for (int i = 0; i < 16; ++i) { const int l = i ^ j;
                if (l > i) { const int x = a[i], y = a[l], lo = x < y ? x : y, hg = x < y ? y : x; const bool asc = (i & k) == 0; a[i] = asc ? lo : hg; a[l] = asc ? hg : lo; } }
}

__device__ __forceinline__ void m2_select(Frame& F, int l, int bgp) {
    FRAME_REFRESH(F);
    const bf16* const KC = P_KC;
    const int pt = bgp >> 5, bg = bgp & 31, b = bg >> 1, g = bg & 1; const bf16* const PROJ = P_PROJ_B(b);
    const int p0 = 256 * pt, pw = p0 + 32 * F.wave, q = F.lane & 31, hi = F.lane >> 5, pos = pw + q;
    const size_t rowq = (size_t)b * SEQ + pos;
    LAS bf16* KCs = (LAS bf16*)F.lds;
#pragma unroll
    for (int i = 0; i < 2; ++i) { const int idx = F.tid + 512 * i;
        { const int key = idx >> 3, ch = idx & 7; *(LAS v4u*)(KCs + key * 72 + 8 * ch) = *(const v4u*)(KC + ((size_t)bg * 128 + key) * 64 + 8 * ch); } }
    bf16x8 qf3[3][4];
#pragma unroll
    for (int hh = 0; hh < 3; ++hh)
#pragma unroll
        for (int ds = 0; ds < 4; ++ds) qf3[hh][ds] = *(const bf16x8*)(PROJ + rowq * NPROJ + C_Q + (g * 3 + hh) * 64 + 16 * ds + 8 * hi);
    __syncthreads();
    const int prow = kperm(q);
    const int pws = __builtin_amdgcn_readfirstlane(pw);
    const int nst = (pws >> 9) + 1, nfull = (pws >= 527) ? ((pws - 527) >> 9) + 1 : 0;
    unsigned selmask;
    {
        float loc[8][3];
#pragma unroll
        for (int G = 0; G < 8; ++G) { loc[G][0] = 0.f; loc[G][1] = 0.f; loc[G][2] = 0.f; }
#pragma unroll
        for (int hh = 0; hh < 3; ++hh) {
            bf16x8 qf[4];
#pragma unroll
            for (int ds = 0; ds < 4; ++ds) qf[ds] = qf3[hh][ds];
            f32x16 s[4]; float mx;
            { int dc = pos - 128 * hi - 31; asm volatile("" : "+v"(dc)); cmp_scores(KCs, qf, s, mx, dc, prow, hi, nst, nfull); }
            const float msafe = (mx == NEG_INF) ? 0.f : mx;
            float ps = 0.f;
#pragma unroll
            for (int st = 0; st < 4; ++st) if (st < nst) {
#pragma unroll
                for (int r = 0; r < 16; ++r) { const float p = ex2(s[st][r] - msafe); s[st][r] = p; ps += p; } }
            ps += shx(ps, 32, F.lane);
            const float inv = 1.0f / fmaxf(ps, 1e-30f);
#pragma unroll
            for (int st = 0; st < 4; ++st) if (st < nst)
#pragma unroll
                for (int u = 0; u < 2; ++u) { const int G = 2 * st + u; const int r0 = 8 * u;
                    loc[G][0] += (s[st][r0 + 0] + s[st][r0 + 1] + s[st][r0 + 2] + 0.5f * s[st][r0 + 3]) * inv;
                    loc[G][1] += (0.5f * s[st][r0 + 3] + s[st][r0 + 4] + s[st][r0 + 5] + s[st][r0 + 6] + 0.5f * s[st][r0 + 7]) * inv;
                    loc[G][2] += (0.5f * s[st][r0 + 7]) * inv; }
        }
        float imp[32];
#pragma unroll
        for (int G = 0; G < 8; ++G) {
            const float o0 = shx(loc[G][0], 32, F.lane), o1 = shx(loc[G][1], 32, F.lane), o2 = shx(loc[G][2], 32, F.lane);
            const float a0 = hi ? o0 : loc[G][0], a1 = hi ? o1 : loc[G][1], a2 = hi ? o2 : loc[G][2];
            const float b0 = hi ? loc[G][0] : o0, b1 = hi ? loc[G][1] : o1, b2 = hi ? loc[G][2] : o2;
            if (G == 0) imp[0] = a0; else imp[4 * G] += a0;
            imp[4 * G + 1] = a1; imp[4 * G + 2] = a2 + b0; imp[4 * G + 3] = b1;
            if (G < 7) imp[4 * G + 4] = b2;
        }
        const int curq = pos >> 6;
#pragma unroll
        for (int j = 0; j < 32; ++j) { float v = imp[j]; if (j == 0 || j == curq || j == curq - 1) v = 1.0e4f; if (j > curq) v = -1.0e4f; imp[j] = v; }
        int key[32];
#pragma unroll
        for (int j = 0; j < 32; ++j) { const unsigned u = __builtin_bit_cast(unsigned, imp[j]); const unsigned ord = (u & 0x80000000u) ? ~u : (u | 0x80000000u);
            key[j] = (int)(((ord >> 1) & ~31u) | (unsigned)(31 - j)); }
        int ka[16], kb[16];
#pragma unroll
        for (int j = 0; j < 16; ++j) { ka[j] = key[j]; kb[j] = key[16 + j]; }
        sort16(ka); sort16(kb);
        int thr = 0x7fffffff;
#pragma unroll
        for (int j = 0; j < 16; ++j) { const int mj = ka[j] > kb[15 - j] ? ka[j] : kb[15 - j]; thr = mj < thr ? mj : thr; }
        unsigned m16 = 0u;
#pragma unroll
        for (int jj = 0; jj < 16; ++jj) { const int kj = hi ? key[16 + jj] : key[jj]; m16 |= (((unsigned)(kj - thr) >> 31) ^ 1u) << jj; }
        selmask = hi ? (m16 << 16) : m16; selmask |= shxu(selmask, 32, F.lane);
    }
    if (hi == 0) __hip_atomic_store(P_SELM(l) + (size_t)bg * SEQ + pos, selmask, __ATOMIC_RELAXED, __HIP_MEMORY_SCOPE_AGENT);
    __syncthreads();
}

__device__ __forceinline__ void m2_nsa(Frame& F, int l, int uid) {
    FRAME_REFRESH(F);
    const bf16* const KC = P_KC; const bf16* const VCT = P_VC; const bf16* const VT = P_VT;
    const int h = uid % 3, bgp = uid / 3, pt = bgp >> 5, bg = bgp & 31, b = bg >> 1, g = bg & 1; const bf16* const PROJ = P_PROJ_B(b); bf16* const MIXED = P_MIXED_B(b);
    const int p0 = 256 * pt, pw = p0 + 32 * F.wave, q = F.lane & 31, hi = F.lane >> 5, pos = pw + q, cur = pw >> 6;
    const size_t rowq = (size_t)b * SEQ + pos;
    LAS bf16* KCs = (LAS bf16*)F.lds;
    LAS bf16* VCt = (LAS bf16*)(F.lds + 18432);
    LAS bf16* Ks0 = (LAS bf16*)(F.lds + 35840);
    LAS bf16* Vs0 = (LAS bf16*)(F.lds + 54272);
    LAS bf16* Kw0 = (LAS bf16*)(F.lds + 72704);
    LAS bf16* Vw0 = (LAS bf16*)(F.lds + 91136);
    v4u stk[2], stv[2];
#pragma unroll
    for (int i = 0; i < 2; ++i) { const int idx = F.tid + 512 * i;
        { const int key = idx >> 3, ch = idx & 7; stk[i] = *(const v4u*)(KC + ((size_t)bg * 128 + key) * 64 + 8 * ch); }
        { const int d = idx >> 4, ch = idx & 15; stv[i] = *(const v4u*)(VCT + ((size_t)bg * 64 + d) * 128 + 8 * ch); } }
    unsigned selmask;
    { unsigned* const sp_ = P_SELM(l) + (size_t)bg * SEQ + pos; unsigned n_ = 0u;
        do { selmask = xb_ld(sp_); } while (selmask == 0u && ++n_ < (1u << 22)); }
#pragma unroll
    for (int i = 0; i < 2; ++i) { const int idx = F.tid + 512 * i;
        { const int key = idx >> 3, ch = idx & 7; *(LAS v4u*)(KCs + key * 72 + 8 * ch) = stk[i]; }
        { const int d = idx >> 4, ch = idx & 15; *(LAS v4u*)(VCt + d * 136 + 8 * ch) = stv[i]; } }
    __syncthreads();
    const int prow = kperm(q);
    const int pws = __builtin_amdgcn_readfirstlane(pw);
    const int nst = (pws >> 9) + 1, nfull = (pws >= 527) ? ((pws - 527) >> 9) + 1 : 0;
    const int kkey = F.tid >> 3, kch = F.tid & 7;
    const int t_hi = (p0 + 255) >> 6;
    const int w_lo = (p0 >= 511) ? ((p0 - 511) >> 6) : 0;
    bf16x8 qf[4];
#pragma unroll
    for (int ds = 0; ds < 4; ++ds) qf[ds] = *(const bf16x8*)(PROJ + rowq * NPROJ + C_Q + (g * 3 + h) * 64 + 16 * ds + 8 * hi);
    const bf16* gp = PROJ + rowq * NPROJ + C_GATE + (g * 3 + h) * 3;
    const float g0 = sigmoidf_(bf2f(gp[0])), g1 = sigmoidf_(bf2f(gp[1])), g2 = sigmoidf_(bf2f(gp[2]));
    f32x16 accO[2];
    f32x16 zero16;
#pragma unroll
    for (int e = 0; e < 16; ++e) zero16[e] = 0.f;
    asm volatile("" : "+v"(zero16));
    {
        const bf16* gKs = PROJ + ((size_t)b * SEQ + kkey) * NPROJ + C_KV + ((1 * 2 + 0) * 2 + g) * 64 + 8 * kch;
        const bf16* gKw = PROJ + ((size_t)b * SEQ + kkey) * NPROJ + C_KV + ((2 * 2 + 0) * 2 + g) * 64 + 8 * kch;
        const bf16* gVs = VT + ((size_t)((b * 2 + 0) * 2 + g) * 64 + kkey) * SEQ + 8 * kch;
        const bf16* gVw = VT + ((size_t)((b * 2 + 1) * 2 + g) * 64 + kkey) * SEQ + 8 * kch;
        const int lofs = kkey * 72 + 8 * kch;
        f32x16 os[2], ow[2]; float ms = 0.f, rs_ = NEG_INF, ls = 0.f, mw = 0.f, rw_ = NEG_INF, lw = 0.f;
#pragma unroll
        for (int dt = 0; dt < 2; ++dt)
#pragma unroll
            for (int e = 0; e < 16; ++e) { os[dt][e] = 0.f; ow[dt][e] = 0.f; }
        v4u ksr, vsr, kwr = (v4u){0u, 0u, 0u, 0u}, vwr = (v4u){0u, 0u, 0u, 0u};
        ksr = *(const v4u*)gKs; vsr = *(const v4u*)gVs;
        if (w_lo == 0) { kwr = *(const v4u*)gKw; vwr = *(const v4u*)gVw; }
        *(LAS v4u*)(Ks0 + lofs) = ksr; *(LAS v4u*)(Vs0 + lofs) = vsr; *(LAS v4u*)(Kw0 + lofs) = kwr; *(LAS v4u*)(Vw0 + lofs) = vwr;
        __syncthreads();
#pragma unroll 1
        for (int jt = 0; jt <= t_hi; ++jt) {
            const int nb = jt & 1;
            if (jt < t_hi) { ksr = *(const v4u*)(gKs + (size_t)(64 * (jt + 1)) * NPROJ); vsr = *(const v4u*)(gVs + 64 * (jt + 1));
                if (jt + 1 >= w_lo) { kwr = *(const v4u*)(gKw + (size_t)(64 * (jt + 1)) * NPROJ); vwr = *(const v4u*)(gVw + 64 * (jt + 1)); } }
            int dd = pos - 64 * jt - 8 * hi;
            {
                const bool sel = (selmask >> jt) & 1u;
                if (jt <= cur && __any(sel)) {
                    const int kind = (jt < cur) ? (__all(sel) ? 0 : 2) : 1;
                    int ds_ = (jt < cur) ? (sel ? 0 : -1) : (sel ? dd : -1); asm volatile("" : "+v"(ds_));
                    attn_tile<0>(Ks0 + nb * 4608, Vs0 + nb * 4608, qf, os, ms, rs_, ls, ds_, kind, q, hi, zero16);
                }
            }
            if (64 * jt + 63 + 511 >= pw && 64 * jt <= pw + 31) {
                const int kind = (64 * jt + 63 <= pw && 64 * jt + 511 >= pw + 31) ? 0 : 1;
                asm volatile("" : "+v"(dd));
                attn_tile<1>(Kw0 + nb * 4608, Vw0 + nb * 4608, qf, ow, mw, rw_, lw, dd, kind, q, hi, zero16);
            }
            if (jt < t_hi) { const int o2 = (nb ^ 1) * 4608 + lofs; *(LAS v4u*)(Ks0 + o2) = ksr; *(LAS v4u*)(Vs0 + o2) = vsr; if (jt + 1 >= w_lo) { *(LAS v4u*)(Kw0 + o2) = kwr; *(LAS v4u*)(Vw0 + o2) = vwr; } }
            __syncthreads();
        }
        ls += shx(ls, 32, F.lane); lw += shx(lw, 32, F.lane);
        const float s1 = g1 / fmaxf(ls, 1e-30f), s2 = g2 / fmaxf(lw, 1e-30f);
        accO[0] = os[0] * s1 + ow[0] * s2; accO[1] = os[1] * s1 + ow[1] * s2;
    }
    {
        f32x16 s[4]; float mx;
        { int dc = pos - 128 * hi - 31; asm volatile("" : "+v"(dc)); cmp_scores(KCs, qf, s, mx, dc, prow, hi, nst, nfull); }
        const float msafe = (mx == NEG_INF) ? 0.f : mx;
        float ps = 0.f;
#pragma unroll
        for (int st = 0; st < 4; ++st) if (st < nst) {
#pragma unroll
            for (int r = 0; r < 16; ++r) { const float p = ex2(s[st][r] - msafe); s[st][r] = p; ps += p; } }
        ps += shx(ps, 32, F.lane);
        const float sc = g0 / fmaxf(ps, 1e-30f);
#pragma unroll
        for (int dt = 0; dt < 2; ++dt) {
            f32x16 o;
#pragma unroll
            for (int e = 0; e < 16; ++e) o[e] = 0.f;
            bf16x8 vf[8];
#pragma unroll
            for (int k = 0; k < 8; ++k) vf[k] = *(const LAS bf16x8*)(VCt + (32 * dt + q) * 136 + 16 * k + 8 * hi);
#pragma unroll
            for (int k = 0; k < 8; ++k) if ((k >> 1) < nst) o = mma32(vf[k], pack8(s[k >> 1], k & 1), o);
            accO[dt] = accO[dt] + o * sc;
        }
    }
    bf16* op = MIXED + rowq * D + (g * 3 + h) * 64 + 4 * hi;
#pragma unroll
    for (int dt = 0; dt < 2; ++dt)
#pragma unroll
        for (int rg = 0; rg < 4; ++rg) { v2u w; w.x = pk2(accO[dt][4 * rg + 0], accO[dt][4 * rg + 1]); w.y = pk2(accO[dt][4 * rg + 2], accO[dt][4 * rg + 3]); *(v2u*)(op + 32 * dt + 8 * rg) = w; }
    __syncthreads();
}
__device__ const unsigned short M2_OFFS[257] = {0,4,8,12,16,20,24,28,32,36,40,44,48,52,56,60,64,68,72,76,80,84,88,92,96,100,104,108,112,116,120,124,128,132,136,140,144,148,152,156,160,164,168,172,176,180,184,188,192,196,200,204,208,212,216,220,224,228,232,236,240,244,248,252,256,260,264,268,272,276,280,284,288,292,296,300,304,308,312,316,320,324,328,332,336,340,344,348,352,356,360,364,368,372,376,380,384,389,394,399,404,409,414,419,424,429,434,439,444,449,454,459,464,469,474,479,484,489,494,499,504,509,514,519,524,529,534,539,544,549,554,559,564,569,574,579,584,589,594,599,604,609,614,619,624,629,634,639,644,649,654,659,664,669,674,679,684,689,694,699,704,708,712,716,720,724,728,732,736,740,744,748,752,756,760,764,768,772,776,780,784,788,792,796,800,804,808,812,816,820,824,828,832,837,842,847,852,857,862,867,872,877,882,887,892,897,902,907,912,917,922,927,932,937,942,947,952,957,962,967,972,977,982,987,992,997,1002,1007,1012,1017,1022,1027,1032,1037,1042,1047,1052,1057,1062,1067,1072,1077,1082,1087,1092,1097,1102,1107,1112,1117,1122,1127,1132,1137,1142,1147,1152};
__device__ const unsigned short M2_LIST[1152] = {672,496,774,1027,673,497,782,1035,674,498,790,1043,675,499,798,1051,676,500,806,1059,677,501,814,1067,678,502,822,1075,679,503,830,1083,680,504,838,1091,681,505,846,1099,682,506,854,1107,683,507,862,1115,684,508,870,1123,685,509,878,1131,686,510,886,1139,687,511,894,1147,688,512,775,770,689,513,783,778,690,514,791,786,691,515,799,794,692,516,807,802,693,517,815,810,694,518,823,818,695,519,831,826,696,520,839,834,697,521,847,842,698,522,855,850,699,523,863,858,700,524,871,866,701,525,879,874,702,526,887,882,703,527,895,890,704,528,160,896,705,529,161,904,706,530,162,912,707,531,163,920,708,532,164,928,709,533,165,936,710,534,166,944,711,535,167,952,712,536,168,960,713,537,169,968,714,538,170,976,715,539,171,984,716,540,172,992,717,541,173,1000,718,542,174,1008,719,543,175,1016,720,480,176,1024,721,481,177,1032,722,482,178,1040,723,483,179,1048,724,484,180,1056,725,485,181,1064,726,486,182,1072,727,487,183,1080,728,488,184,1088,729,489,185,1096,730,490,186,1104,731,491,187,1112,732,492,188,1120,733,493,189,1128,734,494,190,1136,735,495,191,1144,736,192,224,128,737,193,225,129,738,194,226,130,739,195,227,131,740,196,228,132,741,197,229,133,742,198,230,134,743,199,231,135,744,200,232,136,745,201,233,137,746,202,234,138,747,203,235,139,748,204,236,140,749,205,237,141,750,206,238,142,751,207,239,143,752,208,240,144,753,209,241,145,754,210,242,146,755,211,243,147,756,212,244,148,757,213,245,149,758,214,246,150,759,215,247,151,760,216,248,152,761,217,249,153,762,218,250,154,763,219,251,155,764,220,252,156,765,221,253,157,766,222,254,158,767,223,255,159,576,368,1028,897,64,577,369,1036,905,65,578,370,1044,913,66,579,371,1052,921,67,580,372,1060,929,68,581,373,1068,937,69,582,374,1076,945,70,583,375,1084,953,71,584,376,1092,961,72,585,377,1100,969,73,586,378,1108,977,74,587,379,1116,985,75,588,380,1124,993,76,589,381,1132,1001,77,590,382,1140,1009,78,591,383,1148,1017,79,592,304,903,771,0,593,305,911,779,1,594,306,919,787,2,595,307,927,795,3,596,308,935,803,4,597,309,943,811,5,598,310,951,819,6,599,311,959,827,7,600,312,967,835,8,601,313,975,843,9,602,314,983,851,10,603,315,991,859,11,604,316,999,867,12,605,317,1007,875,13,606,318,1015,883,14,607,319,1023,891,15,608,288,1031,899,16,609,289,1039,907,17,610,290,1047,915,18,611,291,1055,923,19,612,292,1063,931,20,613,293,1071,939,21,614,294,1079,947,22,615,295,1087,955,23,616,296,1095,963,24,617,297,1103,971,25,618,298,1111,979,26,619,299,1119,987,27,620,300,1127,995,28,621,301,1135,1003,29,622,302,1143,1011,30,623,303,1151,1019,31,624,320,1029,769,80,625,321,1037,777,81,626,322,1045,785,82,627,323,1053,793,83,628,324,1061,801,84,629,325,1069,809,85,630,326,1077,817,86,631,327,1085,825,87,632,328,1093,833,88,633,329,1101,841,89,634,330,1109,849,90,635,331,1117,857,91,636,332,1125,865,92,637,333,1133,873,93,638,334,1141,881,94,639,335,1149,889,95,640,448,256,1025,641,449,257,1033,642,450,258,1041,643,451,259,1049,644,452,260,1057,645,453,261,1065,646,454,262,1073,647,455,263,1081,648,456,264,1089,649,457,265,1097,650,458,266,1105,651,459,267,1113,652,460,268,1121,653,461,269,1129,654,462,270,1137,655,463,271,1145,656,432,272,768,657,433,273,776,658,434,274,784,659,435,275,792,660,436,276,800,661,437,277,808,662,438,278,816,663,439,279,824,664,440,280,832,665,441,281,840,666,442,282,848,667,443,283,856,668,444,284,864,669,445,285,872,670,446,286,880,671,447,287,888,544,416,902,772,32,545,417,910,780,33,546,418,918,788,34,547,419,926,796,35,548,420,934,804,36,549,421,942,812,37,550,422,950,820,38,551,423,958,828,39,552,424,966,836,40,553,425,974,844,41,554,426,982,852,42,555,427,990,860,43,556,428,998,868,44,557,429,1006,876,45,558,430,1014,884,46,559,431,1022,892,47,560,464,1030,900,48,561,465,1038,908,49,562,466,1046,916,50,563,467,1054,924,51,564,468,1062,932,52,565,469,1070,940,53,566,470,1078,948,54,567,471,1086,956,55,568,472,1094,964,56,569,473,1102,972,57,570,474,1110,980,58,571,475,1118,988,59,572,476,1126,996,60,573,477,1134,1004,61,574,478,1142,1012,62,575,479,1150,1020,63,384,336,96,773,898,385,337,97,781,906,386,338,98,789,914,387,339,99,797,922,388,340,100,805,930,389,341,101,813,938,390,342,102,821,946,391,343,103,829,954,392,344,104,837,962,393,345,105,845,970,394,346,106,853,978,395,347,107,861,986,396,348,108,869,994,397,349,109,877,1002,398,350,110,885,1010,399,351,111,893,1018,400,352,112,901,1026,401,353,113,909,1034,402,354,114,917,1042,403,355,115,925,1050,404,356,116,933,1058,405,357,117,941,1066,406,358,118,949,1074,407,359,119,957,1082,408,360,120,965,1090,409,361,121,973,1098,410,362,122,981,1106,411,363,123,989,1114,412,364,124,997,1122,413,365,125,1005,1130,414,366,126,1013,1138,415,367,127,1021,1146};
__device__ const unsigned short M2L_OFFS[33] = {0,2,4,6,8,10,12,15,18,22,26,30,34,37,40,44,48,51,54,57,61,65,68,71,75,78,81,84,88,91,95,99,102};
__device__ const unsigned short M2L_LIST[102] = {96,49,99,48,100,54,101,59,97,57,98,55,38,44,89,28,56,90,6,18,47,87,5,20,46,86,1,14,39,92,2,19,41,84,36,42,85,37,43,91,10,26,34,75,7,21,40,88,29,51,94,22,80,93,33,45,95,8,12,53,81,3,23,50,82,31,67,77,24,69,72,11,16,62,68,35,60,74,32,64,76,27,65,78,9,15,58,79,30,70,83,4,13,61,63,0,17,52,73,25,66,71};


#ifndef MK_PER_PHASE
#define MK_PER_PHASE 0
#endif
constexpr int PH_PER_LAYER = 6;
constexpr int N_PHASES = 2 + PH_PER_LAYER * DEPTH;
__global__ void __launch_bounds__(NWAVES * 64, 2) hymba_fwd(Args args) {
    extern __shared__ __attribute__((aligned(16))) unsigned char lds[];
    Frame F;
    F.lds = (LAS unsigned char*)lds;
    F.G = gridDim.x; F.wave0 = __builtin_amdgcn_readfirstlane((int)threadIdx.x >> 6); F.cid = blockIdx.x; F.lok = 0; FRAME_REFRESH(F);
    for (int u = F.tid; u < (LDS_BYTES - LDSCTL_OFF) / 4; u += NWAVES * 64) ((LAS unsigned*)(F.lds + LDSCTL_OFF))[u] = 0u;
    __syncthreads();
    unsigned* barw = (unsigned*)(args.ws + WS_CTL) + CW_BAR;
    XcdBarrier bar; bar.bar = barw; bar.x = 0; bar.st = nullptr;
    if (!MK_PER_PHASE) bar = xcd_barrier_post(barw, (volatile LAS unsigned*)(F.lds + LDSCTL_OFF + 64));
    const int lo = args.ph_lo, hi = args.ph_hi;
#define IN(k) (lo <= (k) && (k) < hi)
#define SEAM(k) do { if (!MK_PER_PHASE && IN(k) && IN((k) + 1)) { unsigned* bb_ = (unsigned*)(P_WS + WS_CTL) + CW_BAR; bar.bar = bb_; FRAME_REFRESH(F); xcd_barrier(bar, F.tid == 0); } } while (0)

#define SEAML(k) do { if (!MK_PER_PHASE && IN(k) && IN((k) + 1)) { unsigned* bb_ = (unsigned*)(P_WS + WS_CTL) + CW_BAR; bar.bar = bb_; FRAME_REFRESH(F); if (F.lok) xcd_barrier_local(bar, F.tid == 0); else xcd_barrier(bar, F.tid == 0); } } while (0)
    if (IN(0)) { FRAME_REFRESH(F); p0_prologue(F); }
    SEAM(0);
    if (!MK_PER_PHASE && IN(0) && IN(1)) {
        volatile LAS int* lw = (volatile LAS int*)(F.lds + LDSCTL_OFF + 64);
        FRAME_REFRESH(F);
        if (F.tid == 0) lw[4] = xcd_local_id(bar, (unsigned)F.G);
        __syncthreads();
        const int id_ = __builtin_amdgcn_readfirstlane(lw[4]);
        if (id_ >= 0) { F.cid = id_; F.lok = 1; }
    }
#pragma unroll 1
    for (int l = 0; l < DEPTH; ++l) {
        const int pb = 1 + PH_PER_LAYER * l;
        if (IN(pb + 0)) {
            FRAME_REFRESH(F);
            pg8::Gemm g{P_XN, P_WIN + (size_t)l * NPROJ * D, T, NPROJ, D}; pg8::StaticOrder S; S.init(T, NPROJ, F.G, (int)F.bid);
            pg8::EpiProj E{P_PROJ, P_rope, NPROJ, QSCALE, l == 0 ? (const float*)nullptr : (const float*)P_ST(2 * l - 1), P_CV + CV_C1IN + l * NPROJ, P_CV + CV_C2IN + l * NPROJ, SLAB_PADP / 2, (P_IN + 63) / 64 * 64};
            pg8::gemm_phase<pg8::EpiProj, pg8::StaticOrder, true, true>(F.lds, g, S, E, F.wave);
        }
        SEAML(pb + 0);
        if (IN(pb + 1)) {
            FRAME_REFRESH(F);
            if (l == 0) fold_vectors_reduce(F);
#define XUNITS(u, N) for (int k_ = 0, u = F.lok ? (F.bid & 7) * ((N) / 8) + (F.bid >> 3) : F.bid; F.lok ? k_ < (N) / 256 : u < (N); ++k_, u += F.lok ? 32 : F.G)
            XUNITS(u, 256) m1_compress(F, l, u);
            XUNITS(u, 512) m1_vt(F, u);
            XUNITS(u, 512) m1_gla_pool(F, l, u);
        }
        if (l == 0) SEAM(pb + 1); else SEAML(pb + 1);
        if (IN(pb + 2)) {
            FRAME_REFRESH(F);
            if (F.lok) {
                const int x = F.bid & 7, r = F.bid >> 3;
                m2_select(F, l, (r >> 2) * 32 + 4 * x + (r & 3));
#pragma unroll 1
                for (int i = __builtin_amdgcn_readfirstlane((int)M2L_OFFS[r]), i1 = __builtin_amdgcn_readfirstlane((int)M2L_OFFS[r + 1]); i < i1; ++i) { const int lid = __builtin_amdgcn_readfirstlane((int)M2L_LIST[i]);
                    if (lid < 96) { const int hh = lid % 3, t_ = lid / 3; m2_nsa(F, l, ((t_ >> 2) * 32 + 4 * x + (t_ & 3)) * 3 + hh); } else { const int m_ = lid - 96; m2_gla(F, l, 2 * x + m_ / 3, m_ % 3);
                    } }
            } else {
#pragma unroll 1
            for (int w = F.bid; w < 256; w += F.G) m2_select(F, l, w);
#pragma unroll 1
            for (int w = F.bid; w < 256; w += F.G) {
#pragma unroll 1
                for (int i = __builtin_amdgcn_readfirstlane((int)M2_OFFS[w]), i1 = __builtin_amdgcn_readfirstlane((int)M2_OFFS[w + 1]); i < i1; ++i) { const int id = __builtin_amdgcn_readfirstlane((int)M2_LIST[i]);
                    if (id < 768) m2_nsa(F, l, id); else { const int u_ = id - 768; if ((u_ & 7) == 0) m2_gla(F, l, u_ / 24, (u_ >> 3) % 3); } } }
            }
        }
        SEAML(pb + 2);
        if (IN(pb + 3)) {
            FRAME_REFRESH(F);
            pg8::Gemm g{P_MIXED, P_WOUT + (size_t)l * D * D, T, D, D, SLAB_PADM}; pg8::StaticOrder S; S.init(T, D, F.G, (int)F.bid);
            const int kin = l == 0 ? 0 : 2 * l - 1;
            pg8::EpiRes E{l == 0 ? P_x : (const float*)nullptr, P_XN, P_ST(0), P_GB + kin * 2048, D, kin, 2 * l, ALPHA};
            pg8::gemm_phase<pg8::EpiRes, pg8::StaticOrder, true, true>(F.lds, g, S, E, F.wave);
        }
        SEAML(pb + 3);
        if (IN(pb + 4)) {
            FRAME_REFRESH(F);
            pg8::Gemm g{P_XN, P_WUP + (size_t)l * D * FF, T, FF, D}; pg8::StaticOrder S; S.init(T, FF, F.G, (int)F.bid);
            pg8::EpiRelu2 E{P_U, FF, P_ST(2 * l), P_CV + CV_C1UP + l * FF, P_CV + CV_C2UP + l * FF};
            pg8::gemm_phase<pg8::EpiRelu2, pg8::StaticOrder, true, true>(F.lds, g, S, E, F.wave);
        }
        SEAML(pb + 4);
        if (IN(pb + 5)) {
            FRAME_REFRESH(F);
            pg8::Gemm g{P_U, P_WDN + (size_t)l * D * FF, T, D, FF}; pg8::StaticOrder S; S.init(T, D, F.G, (int)F.bid);
            pg8::EpiRes E{(const float*)nullptr, P_XN, P_ST(0), P_GB + (2 * l) * 2048, D, 2 * l, 2 * l + 1, ALPHA};
            pg8::gemm_phase<pg8::EpiRes, pg8::StaticOrder, true, true>(F.lds, g, S, E, F.wave);
        }
        if (l + 1 < DEPTH) SEAML(pb + 5); else SEAM(pb + 5);
    }
    if (IN(1 + PH_PER_LAYER * DEPTH)) { FRAME_REFRESH(F); final_ln_phase(F, P_ST(2 * DEPTH - 1), P_ln2_g + (DEPTH - 1) * D, P_ln2_b + (DEPTH - 1) * D); }
#undef IN
#undef SEAM
}

extern "C" void kernel_launch(void* const* d_in, const int* in_sizes, int n_in, void* d_out, int out_size, void* d_ws, size_t ws_size, hipStream_t stream) {
    static int grid = 0;
    if (grid == 0) {
        if (n_in != 17 || in_sizes[0] != T * D || out_size != T * D || ws_size < WS_END) { fprintf(stderr, "kernel_launch: unexpected problem (n_in %d, in0 %d, out %d, ws %zu); nothing launched\n", n_in, n_in > 0 ? in_sizes[0] : -1, out_size, ws_size); grid = -1; return; }
        int dev = 0, cus = 0, per_cu = 0;
        if (hipGetDevice(&dev) != hipSuccess || hipDeviceGetAttribute(&cus, hipDeviceAttributeMultiprocessorCount, dev) != hipSuccess) { grid = -1; return; }
        if (hipFuncSetAttribute((const void*)hymba_fwd, hipFuncAttributeMaxDynamicSharedMemorySize, LDS_BYTES) != hipSuccess) { fprintf(stderr, "kernel_launch: hipFuncSetAttribute failed\n"); grid = -1; return; }
        if (hipOccupancyMaxActiveBlocksPerMultiprocessor(&per_cu, (const void*)hymba_fwd, NWAVES * 64, LDS_BYTES) != hipSuccess || per_cu < 1) { fprintf(stderr, "kernel_launch: occupancy query says %d blocks per CU\n", per_cu); per_cu = 1; }
        (void)hipGetLastError();
        grid = cus;
    }
    if (grid < 0) return;
    if (hipMemsetAsync((char*)d_ws + WS_CTL, 0, CTL_ZERO_BYTES, stream) != hipSuccess) { fprintf(stderr, "kernel_launch: memset failed\n"); return; }
    Args a{};
    for (int i = 0; i < 17; ++i) a.in[i] = (const float*)d_in[i];
    a.out = (float*)d_out; a.ws = (unsigned char*)d_ws;
#if MK_PER_PHASE
    for (int p = 0; p < N_PHASES; ++p) { a.ph_lo = p; a.ph_hi = p + 1; hipLaunchKernelGGL(hymba_fwd, dim3(grid), dim3(NWAVES * 64), LDS_BYTES, stream, a); }
#else
    a.ph_lo = 0; a.ph_hi = N_PHASES;
    hipLaunchKernelGGL(hymba_fwd, dim3(grid), dim3(NWAVES * 64), LDS_BYTES, stream, a);
#endif
    const hipError_t le = hipPeekAtLastError();
    if (le != hipSuccess) fprintf(stderr, "kernel_launch: launch failed: %s\n", hipGetErrorName(le));
}
```
